# Optimizing an MI355X kernel written in HIP

```python
import jax, jax.numpy as jnp
from jax import lax
import numpy as np

D_MODEL = 1024
BATCH = 16
SEQ = 2048
DEPTH = 4

CONV_WIDTH = D_MODEL // 2
CONV_GROUPS = 8
CONV_K = 3
HEAD_DIM = 64
ATT_WIDTH = D_MODEL - CONV_WIDTH
ATT_HEADS = ATT_WIDTH // HEAD_DIM
IN_WIDTH = 3 * CONV_WIDTH + 3 * ATT_WIDTH
MOBA_BLOCK = 256
MOBA_TOPK = 3
QUERY_CHUNK = 32
ROPE_THETA = 10000.0
N_GROUPS = 4
EXPERTS_PER_GROUP = 4
N_EXPERTS = N_GROUPS * EXPERTS_PER_GROUP
TOP_K_IN_GROUP = 2
D_FF_EXPERT = D_MODEL // 4
EPS = 1e-6
NEG = -1e30

kernel_name = "hymba_conv_moba_hmoe_adaln"


def rmsnorm(x, g):
    xf = x.astype(jnp.float32)
    y = xf * lax.rsqrt(jnp.mean(xf * xf, axis=-1, keepdims=True) + EPS)
    return (y * g.astype(jnp.float32)).astype(x.dtype)


def rope(x, positions):
    dh = x.shape[-1]
    inv_freq = ROPE_THETA ** (-jnp.arange(0, dh, 2, dtype=jnp.float32) / dh)
    ang = positions[:, None, :, None].astype(jnp.float32) * inv_freq
    cos, sin = jnp.cos(ang), jnp.sin(ang)
    xf = x.astype(jnp.float32)
    x1, x2 = xf[..., : dh // 2], xf[..., dh // 2:]
    out = jnp.concatenate([x1 * cos - x2 * sin, x2 * cos + x1 * sin], axis=-1)
    return out.astype(x.dtype)


def short_conv_mixer(u_b, u_c, u_h, conv_w):
    gated = u_c * u_h
    rhs = conv_w.reshape(CONV_K, 1, CONV_WIDTH).astype(gated.dtype)
    conv = lax.conv_general_dilated(
        gated, rhs, window_strides=(1,), padding=[(CONV_K - 1, 0)],
        dimension_numbers=("NWC", "WIO", "NWC"), feature_group_count=CONV_WIDTH)
    return u_b * conv


def moba_attention(q, k, v):
    B, H, S, dh = q.shape
    nb = -(-S // MOBA_BLOCK)
    s_pad = nb * MOBA_BLOCK
    pad = [(0, 0), (0, 0), (0, s_pad - S), (0, 0)]
    kb = jnp.pad(k, pad).reshape(B, H, nb, MOBA_BLOCK, dh)
    vb = jnp.pad(v, pad).reshape(B, H, nb, MOBA_BLOCK, dh)
    kmean = jnp.mean(kb.astype(jnp.float32), axis=3)
    n_sel = max(1, min(MOBA_TOPK, nb - 1))
    scale = HEAD_DIM ** -0.5
    n_chunks = S // QUERY_CHUNK
    gather = jax.vmap(jax.vmap(lambda blocks, ix: blocks[ix]))
    blk = jnp.arange(nb)

    def chunk(ci):
        start = ci * QUERY_CHUNK
        qc = lax.dynamic_slice_in_dim(q, start, QUERY_CHUNK, axis=2)
        own = start // MOBA_BLOCK
        qpos = start + jnp.arange(QUERY_CHUNK)
        kpos = own * MOBA_BLOCK + jnp.arange(MOBA_BLOCK)
        k_own = lax.dynamic_index_in_dim(kb, own, axis=2, keepdims=False)
        v_own = lax.dynamic_index_in_dim(vb, own, axis=2, keepdims=False)
        s_own = jnp.einsum("bhqd,bhkd->bhqk", qc, k_own,
                           preferred_element_type=jnp.float32) * scale
        s_own = jnp.where(kpos[None, :] <= qpos[:, None], s_own, NEG)
        gscore = jnp.einsum("bhqd,bhnd->bhqn", qc.astype(jnp.float32), kmean)
        gscore = jnp.where(blk < own, gscore, NEG)
        _, sel = lax.top_k(gscore, n_sel)
        valid = sel < own
        k_sel = gather(kb, sel)
        v_sel = gather(vb, sel)
        s_sel = jnp.einsum("bhqd,bhqnkd->bhqnk", qc, k_sel,
                           preferred_element_type=jnp.float32) * scale
        s_sel = jnp.where(valid[..., None], s_sel, NEG)
        n_l = n_sel * MOBA_BLOCK
        s_all = jnp.concatenate(
            [s_sel.reshape(B, H, QUERY_CHUNK, n_l), s_own], axis=-1)
        p = jax.nn.softmax(s_all, axis=-1)
        p_sel = p[..., :n_l].reshape(B, H, QUERY_CHUNK, n_sel, MOBA_BLOCK).astype(v.dtype)
        p_own = p[..., n_l:].astype(v.dtype)
        out = (jnp.einsum("bhqnk,bhqnkd->bhqd", p_sel, v_sel)
               + jnp.einsum("bhqk,bhkd->bhqd", p_own, v_own))
        return out.astype(q.dtype)

    outs = lax.map(chunk, jnp.arange(n_chunks))
    return outs.transpose(1, 2, 0, 3, 4).reshape(B, H, S, dh)


def hier_moe(h, w_rg, b_rg, w_re, b_re, w_gate, w_up, w_down):
    B, S, D = h.shape
    n = B * S
    t = h.reshape(n, D)
    tok = jnp.arange(n)
    g_logits = (t @ w_rg).astype(jnp.float32) + b_rg.astype(jnp.float32)
    g_prob = jax.nn.softmax(g_logits, axis=-1)
    g_sel = jnp.argmax(g_logits, axis=-1)
    p_group = g_prob[tok, g_sel]
    e_logits = ((t @ w_re).astype(jnp.float32) + b_re.astype(jnp.float32)
                ).reshape(n, N_GROUPS, EXPERTS_PER_GROUP)
    e_in = e_logits[tok, g_sel]
    top_v, top_i = lax.top_k(e_in, TOP_K_IN_GROUP)
    w_sel = jax.nn.softmax(top_v, axis=-1) * p_group[:, None]
    expert_ids = g_sel[:, None] * EXPERTS_PER_GROUP + top_i
    combine = jnp.sum(jax.nn.one_hot(expert_ids, N_EXPERTS, dtype=jnp.float32)
                      * w_sel[..., None], axis=1)
    hid = (jax.nn.silu(jnp.einsum("nd,edf->nef", t, w_gate))
           * jnp.einsum("nd,edf->nef", t, w_up))
    y = jnp.einsum("nef,efd->nd", hid * combine[:, :, None].astype(hid.dtype), w_down)
    return y.reshape(B, S, D)


def setup_inputs(seed: int = 0) -> dict:
    key = jax.random.key(seed)
    ks = jax.random.split(key, 24)
    f32 = jnp.float32
    D, L = D_MODEL, DEPTH

    def nrm(k, shape, s):
        return jax.random.normal(k, shape, f32) * s

    x = jax.random.normal(ks[0], (BATCH, SEQ, D), f32)
    c = jax.random.normal(ks[1], (BATCH, D), f32)
    offset = jax.random.randint(ks[2], (BATCH, 1), 0, 4096, dtype=jnp.int32)
    positions = offset + jnp.arange(SEQ, dtype=jnp.int32)[None, :]
    return {
        "x": x,
        "c": c,
        "positions": positions,
        "norm1_g": 1.0 + nrm(ks[3], (L, D), 0.02),
        "norm2_g": 1.0 + nrm(ks[4], (L, D), 0.02),
        "w_ada": nrm(ks[5], (L, D, 6 * D), 0.5 * D ** -0.5),
        "b_ada": nrm(ks[6], (L, 6 * D), 0.02),
        "w_in": nrm(ks[7], (L, D, IN_WIDTH), D ** -0.5),
        "conv_w": nrm(ks[8], (L, CONV_K, CONV_WIDTH), CONV_K ** -0.5),
        "q_norm_g": 1.0 + nrm(ks[9], (L, HEAD_DIM), 0.02),
        "k_norm_g": 1.0 + nrm(ks[10], (L, HEAD_DIM), 0.02),
        "conv_out_g": 1.0 + nrm(ks[11], (L, CONV_WIDTH), 0.02),
        "attn_out_g": 1.0 + nrm(ks[12], (L, ATT_WIDTH), 0.02),
        "w_out": nrm(ks[13], (L, D, D), D ** -0.5),
        "w_router_group": nrm(ks[14], (L, D, N_GROUPS), D ** -0.5),
        "b_router_group": nrm(ks[15], (L, N_GROUPS), 0.01),
        "w_router_expert": nrm(ks[16], (L, D, N_EXPERTS), D ** -0.5),
        "b_router_expert": nrm(ks[17], (L, N_EXPERTS), 0.01),
        "w_gate": nrm(ks[18], (L, N_EXPERTS, D, D_FF_EXPERT), D ** -0.5),
        "w_up": nrm(ks[19], (L, N_EXPERTS, D, D_FF_EXPERT), D ** -0.5),
        "w_down": nrm(ks[20], (L, N_EXPERTS, D_FF_EXPERT, D), D_FF_EXPERT ** -0.5),
    }


def reference(x, c, positions, norm1_g, norm2_g, w_ada, b_ada, w_in, conv_w,
              q_norm_g, k_norm_g, conv_out_g, attn_out_g, w_out,
              w_router_group, b_router_group, w_router_expert, b_router_expert,
              w_gate, w_up, w_down):
    B, S, D = x.shape
    cw, aw = CONV_WIDTH, ATT_WIDTH
    split_at = [cw, 2 * cw, 3 * cw, 3 * cw + aw, 3 * cw + 2 * aw]
    c_act = jax.nn.silu(c)

    def heads(u):
        return u.reshape(B, S, ATT_HEADS, HEAD_DIM).transpose(0, 2, 1, 3)

    for l in range(DEPTH):
        mod = (c_act @ w_ada[l] + b_ada[l])[:, None, :]
        shift1, scale1, gate1, shift2, scale2, gate2 = jnp.split(mod, 6, axis=-1)

        h = rmsnorm(x, norm1_g[l]) * (1.0 + scale1) + shift1
        u = h @ w_in[l]
        u_b, u_c, u_h, u_q, u_k, u_v = jnp.split(u, split_at, axis=-1)
        y_conv = short_conv_mixer(u_b, u_c, u_h, conv_w[l])
        q = rope(rmsnorm(heads(u_q), q_norm_g[l]), positions)
        k = rope(rmsnorm(heads(u_k), k_norm_g[l]), positions)
        v = heads(u_v)
        y_att = moba_attention(q, k, v).transpose(0, 2, 1, 3).reshape(B, S, aw)
        y_mix = jnp.concatenate(
            [rmsnorm(y_conv, conv_out_g[l]), rmsnorm(y_att, attn_out_g[l])], axis=-1)
        x = x + gate1 * (y_mix @ w_out[l])

        h2 = rmsnorm(x, norm2_g[l]) * (1.0 + scale2) + shift2
        x = x + gate2 * hier_moe(h2, w_router_group[l], b_router_group[l],
                                 w_router_expert[l], b_router_expert[l],
                                 w_gate[l], w_up[l], w_down[l])
    return x
```

```cpp
#include <hip/hip_runtime.h>
#include <cstdio>
#include <cstdint>

#define LAS __attribute__((address_space(3)))
#define GAS __attribute__((address_space(1)))
typedef unsigned short bf16_t;
typedef short bf16x8 __attribute__((ext_vector_type(8)));
typedef float f32x4 __attribute__((ext_vector_type(4)));
typedef float f32x2 __attribute__((ext_vector_type(2)));
typedef unsigned u32x4 __attribute__((ext_vector_type(4)));
typedef unsigned u32x2 __attribute__((ext_vector_type(2)));
typedef __bf16 bf16x2_t __attribute__((ext_vector_type(2)));

#ifndef MK_ONE_LAUNCH
#define MK_ONE_LAUNCH 1
#endif

constexpr int D = 1024, NB = 16, SEQ = 2048, DEPTH = 4, NTOK = NB * SEQ;
constexpr int CW = 512, AW = 512, NH = 8, HD = 64, INW = 3072, MBLK = 256, NBLK = SEQ / MBLK;
constexpr int NE = 16, FF = 256, NCLS = 24;
constexpr float EPS = 1e-6f;
constexpr float C2 = 0.125f * 1.4426950408889634f;
constexpr int NWAVES = 8, NTHR = 512;
constexpr int NPHASE = 3 + 8 * DEPTH;

constexpr size_t MiB = 1u << 20, KiB = 1u << 10;
constexpr size_t WS_CTL = 0, CTL_ZERO_BYTES = 1 * MiB;
constexpr size_t WS_MOD = 1 * MiB;
constexpr size_t WS_GM1 = 2 * MiB + 512 * KiB;
constexpr size_t WS_GM2 = 2 * MiB + 768 * KiB;
constexpr size_t WS_BIAS1 = 3 * MiB;
constexpr size_t WS_BIASR = 3 * MiB + 768 * KiB;
constexpr size_t WS_BIASGU = 4 * MiB;
constexpr size_t WS_SH = 6 * MiB;
constexpr size_t WS_KMEAN = 6 * MiB + 256 * KiB;
constexpr size_t WS_WTS = 6 * MiB + 512 * KiB;
constexpr size_t WS_RINV2 = 6 * MiB + 768 * KiB;
constexpr size_t WS_PART1 = 7 * MiB;
constexpr size_t WS_PART2 = 9 * MiB;
constexpr size_t WS_LIST = 11 * MiB;
constexpr size_t WS_WR = 14 * MiB;
constexpr size_t WS_WIN = 16 * MiB;
constexpr size_t WS_WOUT = 40 * MiB;
constexpr size_t WS_WGU = 48 * MiB;
constexpr size_t WS_WD = 112 * MiB;
constexpr size_t WS_XG = 144 * MiB;
constexpr size_t WS_UBCH = 208 * MiB;
constexpr size_t WS_HID = 208 * MiB;
constexpr size_t WS_Q = 304 * MiB, WS_K = 336 * MiB, WS_V = 368 * MiB;
constexpr size_t WS_YMIX = 400 * MiB;
constexpr size_t WS_YATT = 464 * MiB;
constexpr size_t WS_END = 496 * MiB;
constexpr int CW_BAR = 4096;
constexpr int CW_CNT = 16384;

constexpr int RING_BYTES = 131072;
constexpr int MISC_OFF = RING_BYTES;
constexpr int LDS_BYTES = 147456;

__device__ __forceinline__ unsigned cvtpk(float lo, float hi) { f32x2 v = {lo, hi}; bf16x2_t b = __builtin_convertvector(v, bf16x2_t); return __builtin_bit_cast(unsigned, b); }
__device__ __forceinline__ float bflo(unsigned w) { return __uint_as_float(w << 16); }
__device__ __forceinline__ float bfhi(unsigned w) { return __uint_as_float(w & 0xffff0000u); }
__device__ __forceinline__ unsigned short f2bf(float f) { return (unsigned short)(cvtpk(f, 0.f) & 0xffffu); }
__device__ __forceinline__ float wave_sum(float v) {
#pragma unroll
    for (int o = 1; o < 64; o <<= 1) v += __shfl_xor(v, o);
    return v;
}
__device__ __forceinline__ float wave_max(float v) {
#pragma unroll
    for (int o = 1; o < 64; o <<= 1) v = fmaxf(v, __shfl_xor(v, o));
    return v;
}
__device__ __forceinline__ void unpack8(const u32x4 w, float (&x)[8]) {
    x[0] = bflo(w.x); x[1] = bfhi(w.x); x[2] = bflo(w.y); x[3] = bfhi(w.y); x[4] = bflo(w.z); x[5] = bfhi(w.z); x[6] = bflo(w.w); x[7] = bfhi(w.w);
}
__device__ __forceinline__ u32x4 pack8(const float (&x)[8]) { u32x4 w; w.x = cvtpk(x[0], x[1]); w.y = cvtpk(x[2], x[3]); w.z = cvtpk(x[4], x[5]); w.w = cvtpk(x[6], x[7]); return w; }
__device__ __forceinline__ int perm32(int rho) { const int n = rho >> 4, i = rho & 15; return 8 * (i >> 2) + 4 * n + (i & 3); }
__device__ __forceinline__ int opaque_tid() { int t = threadIdx.x; asm volatile("" : "+v"(t)); return t; }
__device__ __forceinline__ float silu_f(float x) { return x / (1.f + __expf(-x)); }

#define XB_TMO      128
#define XB_XCNT(j)  (256  + 64 * (j))
#define XB_XSUB(j)  (1280 + 64 * (j))
#define XB_XGEN(j)  (2304 + 64 * (j))
#define XB_TOP      3328
#define XB_TOPGEN   3392
#define XCD_BAR_WORDS 3456
#define XB_SPIN_CAP (1u << 18)
__device__ __forceinline__ unsigned xb_ld(unsigned* p)              { return __hip_atomic_load(p, __ATOMIC_RELAXED, __HIP_MEMORY_SCOPE_AGENT); }
__device__ __forceinline__ unsigned xb_add(unsigned* p, unsigned v) { return __hip_atomic_fetch_add(p, v, __ATOMIC_RELAXED, __HIP_MEMORY_SCOPE_AGENT); }
__device__ __forceinline__ unsigned xb_xcc_id() { return (unsigned)__builtin_amdgcn_s_getreg((3 << 11) | 20) & 0xFu; }
#define XB_SPIN(cond, bar) do { unsigned _sp = 0; while (cond) { __builtin_amdgcn_s_sleep(1); \
    if ((++_sp & 255u) == 0u) { if (xb_ld(&(bar)[XB_TMO])) break; if (_sp > XB_SPIN_CAP) { atomicAdd(&(bar)[XB_TMO], 1u); break; } } } } while (0)
struct XcdBarrier { unsigned* bar; unsigned x; volatile LAS unsigned* st; };
__device__ __forceinline__ XcdBarrier xcd_barrier_post(unsigned* bar, volatile LAS unsigned* st) {
    XcdBarrier b; b.bar = bar; b.x = xb_xcc_id(); b.st = st;
    if (threadIdx.x == 0) (void)xb_add(&bar[XB_XCNT(b.x)], 1u);
    return b;
}
__device__ __forceinline__ void xcd_barrier_complete(unsigned* bar, unsigned x, unsigned& nloc, unsigned& nx) {
    const unsigned G = gridDim.x * gridDim.y * gridDim.z;
    unsigned sum, cnt, mine, sp = 0u;
    for (;;) {
        sum = 0u; cnt = 0u; mine = 0u;
#pragma unroll
        for (unsigned j = 0; j < 16; ++j) { const unsigned c = xb_ld(&bar[XB_XCNT(j)]); sum += c; cnt += (c > 0u) ? 1u : 0u; mine = (j == x) ? c : mine; }
        if (sum == G) break;
        __builtin_amdgcn_s_sleep(1);
        if ((++sp & 255u) == 0u) { if (xb_ld(&bar[XB_TMO])) break; if (sp > XB_SPIN_CAP) { atomicAdd(&bar[XB_TMO], 1u); break; } }
    }
    nloc = mine > 0u ? mine : 1u; nx = cnt > 0u ? cnt : 1u;
}
__device__ __forceinline__ void xcd_barrier(const XcdBarrier& b) {
    asm volatile("s_waitcnt vmcnt(0)" ::: "memory");
    __syncthreads();
    if (threadIdx.x == 0) {
        unsigned* bar = b.bar;
        __builtin_amdgcn_s_waitcnt(0);
        unsigned nloc = b.st[0], nx = b.st[1];
        if (nloc == 0u) { xcd_barrier_complete(bar, b.x, nloc, nx); b.st[0] = nloc; b.st[1] = nx; }
        const unsigned old = xb_add(&bar[XB_XSUB(b.x)], 1u);
        const unsigned gen = old / nloc;
        if (old + 1u == (gen + 1u) * nloc) {
            __builtin_amdgcn_fence(__ATOMIC_RELEASE, "agent");
            asm volatile("s_waitcnt vmcnt(0)" ::: "memory");
            const unsigned og = xb_add(&bar[XB_TOP], 1u);
            const unsigned tg = og / nx;
            if (og + 1u == (tg + 1u) * nx) xb_add(&bar[XB_TOPGEN], 1u);
            else XB_SPIN(xb_ld(&bar[XB_TOPGEN]) == tg, bar);
            __builtin_amdgcn_fence(__ATOMIC_ACQUIRE, "agent");
            xb_add(&bar[XB_XGEN(b.x)], 1u);
            asm volatile("s_waitcnt vmcnt(0)" ::: "memory");
        } else {
            XB_SPIN(xb_ld(&bar[XB_XGEN(b.x)]) == gen, bar);
            __builtin_amdgcn_fence(__ATOMIC_ACQUIRE, "agent");
            asm volatile("s_waitcnt vmcnt(0)" ::: "memory");
        }
    }
    __syncthreads();
}

struct Args { const void* in[21]; float* out; unsigned char* ws; int ph_lo, ph_hi; };
struct Ctx {
    const Args* a; unsigned char* ws; float* out;
    int G, vcu, tid, lane, wave;
    __device__ __forceinline__ const float* inf(int i) const { return (const float*)a->in[i]; }
};
#define I_x (C.inf(0))
#define I_c (C.inf(1))
#define I_pos ((const int*)C.a->in[2])
#define I_norm1_g (C.inf(3))
#define I_norm2_g (C.inf(4))
#define I_w_ada (C.inf(5))
#define I_b_ada (C.inf(6))
#define I_w_in (C.inf(7))
#define I_conv_w (C.inf(8))
#define I_q_norm_g (C.inf(9))
#define I_k_norm_g (C.inf(10))
#define I_conv_out_g (C.inf(11))
#define I_attn_out_g (C.inf(12))
#define I_w_out (C.inf(13))
#define I_w_rg (C.inf(14))
#define I_b_rg (C.inf(15))
#define I_w_re (C.inf(16))
#define I_b_re (C.inf(17))
#define I_w_gate (C.inf(18))
#define I_w_up (C.inf(19))
#define I_w_down (C.inf(20))
#define W_ctl ((unsigned*)(C.ws + WS_CTL))
#define W_MOD ((float*)(C.ws + WS_MOD))
#define W_GM1 ((float*)(C.ws + WS_GM1))
#define W_GM2 ((float*)(C.ws + WS_GM2))
#define W_BIAS1 ((float*)(C.ws + WS_BIAS1))
#define W_BIASR ((float*)(C.ws + WS_BIASR))
#define W_BIASGU ((float*)(C.ws + WS_BIASGU))
#define W_KMEAN ((float*)(C.ws + WS_KMEAN))
#define W_WTS ((float*)(C.ws + WS_WTS))
#define W_RINV2 ((float*)(C.ws + WS_RINV2))
#define W_PART1 ((float*)(C.ws + WS_PART1))
#define W_PART2 ((float*)(C.ws + WS_PART2))
#define W_LIST ((int*)(C.ws + WS_LIST))
#define W_SH ((bf16_t*)(C.ws + WS_SH))
#define W_WR ((bf16_t*)(C.ws + WS_WR))
#define W_WIN ((bf16_t*)(C.ws + WS_WIN))
#define W_WOUT ((bf16_t*)(C.ws + WS_WOUT))
#define W_WGU ((bf16_t*)(C.ws + WS_WGU))
#define W_WD ((bf16_t*)(C.ws + WS_WD))
#define W_XG ((bf16_t*)(C.ws + WS_XG))
#define W_UBCH ((bf16_t*)(C.ws + WS_UBCH))
#define W_HID ((bf16_t*)(C.ws + WS_HID))
#define W_Q ((bf16_t*)(C.ws + WS_Q))
#define W_K ((bf16_t*)(C.ws + WS_K))
#define W_V ((bf16_t*)(C.ws + WS_V))
#define W_YMIX ((bf16_t*)(C.ws + WS_YMIX))
#define W_YATT ((bf16_t*)(C.ws + WS_YATT))

struct GUnit {
    const bf16_t* A; const bf16_t* B0; const bf16_t* B1;
    const int* list;
    int row0, rmask, rcnt;
    int lda, ldb, nk, ksplit;
    int pm, pn, x0, x1, x2;
};
__device__ __forceinline__ int unit_row(const GUnit& u, int i) {
    if (u.list) { const int j = i < u.rcnt ? i : u.rcnt - 1; return u.list[j]; }
    return u.row0 + (i & u.rmask);
}
__device__ __forceinline__ int xcd_chunk(int L, int n) { const int q = n / 8, r = n % 8, xcd = L % 8, off = L / 8; return (xcd < r ? xcd * (q + 1) : r * (q + 1) + (xcd - r) * q) + off; }
__device__ __forceinline__ void tile_order(int wgid, int nM, int nN, int& pm, int& pn) {
    const int nig = 8 * nN, gid = wgid / nig, fm = gid * 8, gsz = (nM - fm) < 8 ? (nM - fm) : 8;
    pm = fm + ((wgid % nig) % gsz); pn = (wgid % nig) / gsz;
}

struct SchedDense {
    const bf16_t* A; const bf16_t* Bt; int nM, nN, K, G, c;
    __device__ __forceinline__ bool next(int i, GUnit& u) const {
        const int n = nM * nN; const long L = (long)i * G + c; if (L >= n) return false;
        const int w = xcd_chunk((int)L, n); int pm, pn; tile_order(w, nM, nN, pm, pn);
        u.A = A; u.B0 = Bt + (size_t)pn * 256 * K; u.B1 = u.B0; u.list = nullptr; u.row0 = pm * 256; u.rmask = -1; u.rcnt = 256;
        u.lda = K; u.ldb = K; u.nk = K / 64; u.ksplit = u.nk; u.pm = pm; u.pn = pn; u.x0 = u.x1 = u.x2 = 0; return true;
    }
};
struct SchedBias {
    const Ctx& C; int G, c;
    __device__ __forceinline__ bool next(int i, GUnit& u) const {
        const long L = (long)i * G + c; if (L >= 45 * DEPTH) return false;
        const int l = (int)L / 45, j = (int)L % 45;
        u.list = nullptr; u.row0 = 0; u.rmask = 15; u.rcnt = 256; u.lda = D; u.ldb = D; u.nk = D / 64; u.ksplit = u.nk; u.pm = l; u.pn = j;
        if (j < 12) { u.A = W_SH + (size_t)(l * 2 + 0) * 16 * D; u.B0 = W_WIN + ((size_t)l * INW + j * 256) * D; u.x0 = 0; u.x1 = 0; u.x2 = 0; }
        else if (j < 44) { const int e = (j - 12) >> 1, ch = (j - 12) & 1; u.A = W_SH + (size_t)(l * 2 + 1) * 16 * D; u.B0 = W_WGU + ((size_t)((l * 16 + e) * 2 + ch) * 256) * D; u.x0 = 1; u.x1 = e; u.x2 = ch; }
        else { u.A = W_SH + (size_t)(l * 2 + 1) * 16 * D; u.B0 = W_WR + (size_t)l * 256 * D; u.x0 = 2; u.x1 = 0; u.x2 = 0; }
        u.B1 = u.B0; return true;
    }
};
__device__ __forceinline__ void pair_ab(int pair, int& a, int& b) { a = (pair >= 3) + (pair >= 5); b = (a == 0) ? pair + 1 : (a == 1 ? pair - 1 : 3); }
struct SchedMoe {
    const Ctx& C; int l, G, c; const LAS int* tb; const LAS int* cn; bool down;
    __device__ __forceinline__ bool next(int i, GUnit& u) const {
        const int Tn = tb[NCLS], n = Tn * 4; const long L = (long)i * G + c; if (L >= n) return false;
        const int w = xcd_chunk((int)L, n); const int rt = w >> 2, pn = w & 3;
        int cls = 0;
#pragma unroll 1
        for (int k = 1; k < NCLS; ++k) if (tb[k] <= rt) cls = k;
        const int tic = rt - tb[cls], cnt = cn[cls];
        const int g = cls / 6, pair = cls % 6; int a, b; pair_ab(pair, a, b);
        const int ea = 4 * g + a, eb = 4 * g + b;
        u.pm = rt; u.pn = pn; u.rcnt = cnt - tic * 256; if (u.rcnt > 256) u.rcnt = 256;
        const int* lst = W_LIST + (size_t)cls * NTOK + tic * 256;
        if (!down) {
            const int slot = pn >> 1, ch = pn & 1, e = slot ? eb : ea;
            u.A = W_XG; u.lda = D; u.list = lst; u.row0 = 0; u.rmask = -1;
            u.B0 = W_WGU + ((size_t)((l * 16 + e) * 2 + ch) * 256) * D; u.B1 = u.B0; u.ldb = D; u.nk = 16; u.ksplit = 16;
            u.x0 = e; u.x1 = ch; u.x2 = slot;
        } else {
            u.A = W_HID; u.lda = 512; u.list = nullptr; u.row0 = rt * 256; u.rmask = -1;
            u.B0 = W_WD + ((size_t)(l * 16 + ea) * D + pn * 256) * FF; u.B1 = W_WD + ((size_t)(l * 16 + eb) * D + pn * 256) * FF - 4 * 64; u.ldb = FF; u.nk = 8; u.ksplit = 4;
            u.x0 = cls; u.x1 = tic; u.x2 = 0;
        }
        return true;
    }
};

typedef f32x4 Acc[2][2][4][2];

struct EpiBias {
    const Ctx& C;
    __device__ __forceinline__ void run(Acc& acc, const GUnit& u, int wr, int wc, int fr, int fq, LAS unsigned char*, int) const {
        if (wr != 0) return;
        const int l = u.pm, b = fr;
#pragma unroll
        for (int bj = 0; bj < 2; ++bj)
#pragma unroll
            for (int n = 0; n < 2; ++n) {
                const f32x4 v = acc[0][bj][0][n]; const int cc = 32 * wc + 8 * fq + 4 * n;
                if (u.x0 == 0) { *(f32x4*)(W_BIAS1 + (size_t)(l * 16 + b) * INW + u.pn * 256 + 128 * bj + cc) = v; }
                else if (u.x0 == 1) { *(f32x4*)(W_BIASGU + ((size_t)(l * 16 + b) * 16 + u.x1) * 512 + 256 * bj + u.x2 * 128 + cc) = v; }
                else if (bj == 0 && wc == 0) {
                    f32x4 o = v; const int col = 8 * fq + 4 * n;
#pragma unroll
                    for (int i = 0; i < 4; ++i) { const int cidx = col + i; float add = 0.f; if (cidx < 4) add = I_b_rg[l * 4 + cidx]; else if (cidx & 4) add = I_b_re[l * 16 + 4 * (cidx >> 3) + (cidx & 3)]; o[i] += add; }
                    *(f32x4*)(W_BIASR + (size_t)(l * 16 + b) * 32 + col) = o;
                }
            }
    }
};

struct EpiG1 {
    const Ctx& C; int l;
    __device__ __forceinline__ void run(Acc& acc, const GUnit& u, int wr, int wc, int fr, int fq, LAS unsigned char*, int) const {
        const int pm = u.pm, pn = u.pn, b = pm >> 3;
        bf16_t* dst; int ldd, colt;
        if (pn < 6) { dst = W_UBCH; ldd = 1536; colt = pn * 256; } else if (pn < 8) { dst = W_Q; ldd = 512; colt = (pn - 6) * 256; }
        else if (pn < 10) { dst = W_K; ldd = 512; colt = (pn - 8) * 256; } else { dst = W_V; ldd = 512; colt = (pn - 10) * 256; }
        const float* bias = W_BIAS1 + (size_t)(l * 16 + b) * INW + pn * 256 + 32 * wc + 8 * fq;
        f32x4 bv[2][2];
#pragma unroll
        for (int bj = 0; bj < 2; ++bj)
#pragma unroll
            for (int n = 0; n < 2; ++n) bv[bj][n] = *(const f32x4*)(bias + 128 * bj + 4 * n);
#pragma unroll
        for (int ai = 0; ai < 2; ++ai)
#pragma unroll
            for (int m = 0; m < 4; ++m) {
                const int tok = pm * 256 + 128 * ai + 64 * wr + 16 * m + fr;
                const f32x4* pp = (const f32x4*)(W_PART1 + (size_t)tok * 16);
                const f32x4 p0 = pp[0], p1 = pp[1], p2 = pp[2], p3 = pp[3];
                const float ss = ((p0.x + p0.y) + (p0.z + p0.w)) + ((p1.x + p1.y) + (p1.z + p1.w)) + ((p2.x + p2.y) + (p2.z + p2.w)) + ((p3.x + p3.y) + (p3.z + p3.w));
                const float r = 1.0f / sqrtf(ss * (1.f / D) + EPS);
#pragma unroll
                for (int bj = 0; bj < 2; ++bj) {
                    const f32x4 v0 = acc[ai][bj][m][0] * r + bv[bj][0], v1 = acc[ai][bj][m][1] * r + bv[bj][1];
                    u32x4 w; w.x = cvtpk(v0.x, v0.y); w.y = cvtpk(v0.z, v0.w); w.z = cvtpk(v1.x, v1.y); w.w = cvtpk(v1.z, v1.w);
                    *(u32x4*)(dst + (size_t)tok * ldd + colt + 128 * bj + 32 * wc + 8 * fq) = w;
                }
            }
    }
};

struct EpiG2 {
    const Ctx& C; int l;
    __device__ __forceinline__ void run(Acc& acc, const GUnit& u, int wr, int wc, int fr, int fq, LAS unsigned char*, int) const {
        const int pm = u.pm, pn = u.pn, b = pm >> 3, cb = pn * 256 + 32 * wc + 8 * fq;
        const float* gate = W_MOD + (size_t)(l * 16 + b) * 6144 + 2048 + cb;
        const float* gm = W_GM2 + (size_t)(l * 16 + b) * D + cb;
        const float* xin = (l == 0) ? I_x : C.out;
        f32x4 gv[2][2], mv[2][2];
#pragma unroll
        for (int bj = 0; bj < 2; ++bj)
#pragma unroll
            for (int n = 0; n < 2; ++n) { gv[bj][n] = *(const f32x4*)(gate + 128 * bj + 4 * n); mv[bj][n] = *(const f32x4*)(gm + 128 * bj + 4 * n); }
#pragma unroll
        for (int ai = 0; ai < 2; ++ai)
#pragma unroll
            for (int m = 0; m < 4; ++m) {
                const int tok = pm * 256 + 128 * ai + 64 * wr + 16 * m + fr; float ss = 0.f;
#pragma unroll
                for (int bj = 0; bj < 2; ++bj) {
                    const size_t off = (size_t)tok * D + cb + 128 * bj;
                    const f32x4 x0 = *(const f32x4*)(xin + off), x1 = *(const f32x4*)(xin + off + 4);
                    const f32x4 n0 = x0 + gv[bj][0] * acc[ai][bj][m][0], n1 = x1 + gv[bj][1] * acc[ai][bj][m][1];
                    *(f32x4*)(C.out + off) = n0; *(f32x4*)(C.out + off + 4) = n1;
                    ss += (n0.x * n0.x + n0.y * n0.y) + (n0.z * n0.z + n0.w * n0.w) + (n1.x * n1.x + n1.y * n1.y) + (n1.z * n1.z + n1.w * n1.w);
                    const f32x4 g0 = n0 * mv[bj][0], g1 = n1 * mv[bj][1];
                    u32x4 w; w.x = cvtpk(g0.x, g0.y); w.y = cvtpk(g0.z, g0.w); w.z = cvtpk(g1.x, g1.y); w.w = cvtpk(g1.z, g1.w);
                    *(u32x4*)(W_XG + off) = w;
                }
                ss += __shfl_xor(ss, 16); ss += __shfl_xor(ss, 32);
                if (fq == 0) W_PART2[(size_t)tok * 16 + pn * 4 + wc] = ss;
            }
    }
};

struct EpiR {
    const Ctx& C; int l;
    __device__ __forceinline__ void run(Acc& acc, const GUnit& u, int wr, int wc, int fr, int fq, LAS unsigned char* lds, int tid) const {
        LAS int* hist = (LAS int*)(lds + MISC_OFF + 1024); LAS int* base = hist + 32;
        if (tid < NCLS) hist[tid] = 0;
        __syncthreads();
        const int pm = u.pm, b = pm >> 3;
        int cls_r[8], lr_r[8];
        if (wc == 0) {
            const float* br = W_BIASR + (size_t)(l * 16 + b) * 32;
            const f32x4 bg = *(const f32x4*)(br), be = *(const f32x4*)(br + 8 * fq + 4);
#pragma unroll
            for (int ai = 0; ai < 2; ++ai)
#pragma unroll
                for (int m = 0; m < 4; ++m) {
                    const int tok = pm * 256 + 128 * ai + 64 * wr + 16 * m + fr;
                    const f32x4* pp = (const f32x4*)(W_PART2 + (size_t)tok * 16);
                    const f32x4 p0 = pp[0], p1 = pp[1], p2 = pp[2], p3 = pp[3];
                    const float ss = ((p0.x + p0.y) + (p0.z + p0.w)) + ((p1.x + p1.y) + (p1.z + p1.w)) + ((p2.x + p2.y) + (p2.z + p2.w)) + ((p3.x + p3.y) + (p3.z + p3.w));
                    const float r2 = 1.0f / sqrtf(ss * (1.f / D) + EPS);
                    f32x4 gl = acc[ai][0][m][0] * r2 + bg;
                    const f32x4 el = acc[ai][0][m][1] * r2 + be;
#pragma unroll
                    for (int i = 0; i < 4; ++i) gl[i] = __shfl(gl[i], fr);
                    int gs = 0; float mx = gl[0];
#pragma unroll
                    for (int i = 1; i < 4; ++i) if (gl[i] > mx) { mx = gl[i]; gs = i; }
                    float den = 0.f;
#pragma unroll
                    for (int i = 0; i < 4; ++i) den += __expf(gl[i] - mx);
                    const float pg = 1.f / den;
                    float es[4];
#pragma unroll
                    for (int i = 0; i < 4; ++i) es[i] = __shfl(el[i], fr + 16 * gs);
                    int i1 = 0; float v1 = es[0];
#pragma unroll
                    for (int i = 1; i < 4; ++i) if (es[i] > v1) { v1 = es[i]; i1 = i; }
                    int i2 = -1; float v2 = -INFINITY;
#pragma unroll
                    for (int i = 0; i < 4; ++i) if (i != i1 && (i2 < 0 || es[i] > v2)) { v2 = es[i]; i2 = i; }
                    const float w1 = 1.f / (1.f + __expf(v2 - v1)), w2 = 1.f - w1;
                    const int a = i1 < i2 ? i1 : i2, bq = i1 < i2 ? i2 : i1;
                    const float wa = (i1 < i2 ? w1 : w2) * pg, wb = (i1 < i2 ? w2 : w1) * pg;
                    const int pair = (a == 0) ? bq - 1 : (a == 1 ? bq + 1 : 5);
                    const int cls = gs * 6 + pair;
                    int lr = 0;
                    if (fq == 0) {
                        lr = __hip_atomic_fetch_add(&hist[cls], 1, __ATOMIC_RELAXED, __HIP_MEMORY_SCOPE_WORKGROUP);
                        *(f32x2*)(W_WTS + (size_t)tok * 2) = (f32x2){wa, wb};
                        W_RINV2[tok] = r2;
                    }
                    cls_r[ai * 4 + m] = cls; lr_r[ai * 4 + m] = lr;
                }
        }
        __syncthreads();
        if (tid < NCLS) base[tid] = (int)__hip_atomic_fetch_add(W_ctl + CW_CNT + l * 2048 + tid * 64, (unsigned)hist[tid], __ATOMIC_RELAXED, __HIP_MEMORY_SCOPE_AGENT);
        __syncthreads();
        if (wc == 0 && fq == 0) {
#pragma unroll
            for (int ai = 0; ai < 2; ++ai)
#pragma unroll
                for (int m = 0; m < 4; ++m) {
                    const int tok = pm * 256 + 128 * ai + 64 * wr + 16 * m + fr; const int cls = cls_r[ai * 4 + m];
                    W_LIST[(size_t)cls * NTOK + base[cls] + lr_r[ai * 4 + m]] = tok;
                }
        }
        __syncthreads();
    }
};

struct EpiG3 {
    const Ctx& C; int l;
    __device__ __forceinline__ void run(Acc& acc, const GUnit& u, int wr, int wc, int fr, int fq, LAS unsigned char*, int) const {
        const int e = u.x0, ch = u.x1, slot = u.x2, rt = u.pm;
#pragma unroll
        for (int ai = 0; ai < 2; ++ai)
#pragma unroll
            for (int m = 0; m < 4; ++m) {
                const int rl = 128 * ai + 64 * wr + 16 * m + fr;
                const int tok = u.list[rl < u.rcnt ? rl : u.rcnt - 1];
                const int b = tok >> 11; const float r2 = W_RINV2[tok], wt = W_WTS[(size_t)tok * 2 + slot];
                const float* bg = W_BIASGU + ((size_t)(l * 16 + b) * 16 + e) * 512 + ch * 128 + 32 * wc + 8 * fq;
                float h[8];
#pragma unroll
                for (int n = 0; n < 2; ++n) {
                    const f32x4 g = acc[ai][0][m][n] * r2 + *(const f32x4*)(bg + 4 * n);
                    const f32x4 uu = acc[ai][1][m][n] * r2 + *(const f32x4*)(bg + 256 + 4 * n);
#pragma unroll
                    for (int i = 0; i < 4; ++i) h[4 * n + i] = silu_f(g[i]) * uu[i] * wt;
                }
                *(u32x4*)(W_HID + (size_t)(rt * 256 + rl) * 512 + slot * 256 + ch * 128 + 32 * wc + 8 * fq) = pack8(h);
            }
    }
};

struct EpiG4 {
    const Ctx& C; int l;
    __device__ __forceinline__ void run(Acc& acc, const GUnit& u, int wr, int wc, int fr, int fq, LAS unsigned char*, int) const {
        const int cls = u.x0, tic = u.x1, pn = u.pn, cb = pn * 256 + 32 * wc + 8 * fq;
        const int* lst = W_LIST + (size_t)cls * NTOK + tic * 256;
#pragma unroll
        for (int ai = 0; ai < 2; ++ai)
#pragma unroll
            for (int m = 0; m < 4; ++m) {
                const int rl = 128 * ai + 64 * wr + 16 * m + fr; const bool valid = rl < u.rcnt;
                const int tok = lst[valid ? rl : u.rcnt - 1]; const int b = tok >> 11;
                const float* gate = W_MOD + (size_t)(l * 16 + b) * 6144 + 5120 + cb;
                const float* gm = W_GM1 + (size_t)(((l + 1) & 3) * 16 + b) * D + cb;
                float ss = 0.f;
#pragma unroll
                for (int bj = 0; bj < 2; ++bj) {
                    const size_t off = (size_t)tok * D + cb + 128 * bj;
                    const f32x4 x0 = *(const f32x4*)(C.out + off), x1 = *(const f32x4*)(C.out + off + 4);
                    const f32x4 n0 = x0 + *(const f32x4*)(gate + 128 * bj) * acc[ai][bj][m][0], n1 = x1 + *(const f32x4*)(gate + 128 * bj + 4) * acc[ai][bj][m][1];
                    ss += (n0.x * n0.x + n0.y * n0.y) + (n0.z * n0.z + n0.w * n0.w) + (n1.x * n1.x + n1.y * n1.y) + (n1.z * n1.z + n1.w * n1.w);
                    if (valid) {
                        *(f32x4*)(C.out + off) = n0; *(f32x4*)(C.out + off + 4) = n1;
                        if (l < DEPTH - 1) {
                            const f32x4 g0 = n0 * *(const f32x4*)(gm + 128 * bj), g1 = n1 * *(const f32x4*)(gm + 128 * bj + 4);
                            u32x4 w; w.x = cvtpk(g0.x, g0.y); w.y = cvtpk(g0.z, g0.w); w.z = cvtpk(g1.x, g1.y); w.w = cvtpk(g1.z, g1.w);
                            *(u32x4*)(W_XG + off) = w;
                        }
                    }
                }
                ss += __shfl_xor(ss, 16); ss += __shfl_xor(ss, 32);
                if (valid && fq == 0) W_PART1[(size_t)tok * 16 + pn * 4 + wc] = ss;
            }
    }
};

template <class Epi, class Sched>
__device__ __forceinline__ void gemm_simple(LAS unsigned char* lds, const Sched& S, const Epi& E) {
    const int tid = opaque_tid(), wid = __builtin_amdgcn_readfirstlane(tid >> 6), lane = tid & 63, wr = wid >> 2, wc = wid & 3, fr = lane & 15, fq = lane >> 4;
    GUnit u;
    for (int it = 0; S.next(it, u); ++it) {
        unsigned ra[2][4], rb[2][2];
#pragma unroll
        for (int ai = 0; ai < 2; ++ai)
#pragma unroll
            for (int m = 0; m < 4; ++m) ra[ai][m] = (unsigned)unit_row(u, 128 * ai + 64 * wr + 16 * m + fr) * (unsigned)u.lda + 8u * fq;
#pragma unroll
        for (int bj = 0; bj < 2; ++bj)
#pragma unroll
            for (int n = 0; n < 2; ++n) rb[bj][n] = (unsigned)(128 * bj + 32 * wc + perm32(16 * n + fr)) * (unsigned)u.ldb + 8u * fq;
        Acc acc;
#pragma unroll
        for (int a = 0; a < 2; ++a)
#pragma unroll
            for (int b = 0; b < 2; ++b)
#pragma unroll
                for (int m = 0; m < 4; ++m)
#pragma unroll
                    for (int n = 0; n < 2; ++n) acc[a][b][m][n] = (f32x4){0.f, 0.f, 0.f, 0.f};
        const int nks = 2 * u.nk;
#pragma unroll 1
        for (int ks = 0; ks < nks; ++ks) {
            const bf16_t* Bp = ((ks >> 1) < u.ksplit ? u.B0 : u.B1) + ks * 32;
            const bf16_t* Ap = u.A + ks * 32;
            bf16x8 av[2][4], bv[2][2];
#pragma unroll
            for (int ai = 0; ai < 2; ++ai)
#pragma unroll
                for (int m = 0; m < 4; ++m) av[ai][m] = *(const bf16x8*)(Ap + ra[ai][m]);
#pragma unroll
            for (int bj = 0; bj < 2; ++bj)
#pragma unroll
                for (int n = 0; n < 2; ++n) bv[bj][n] = *(const bf16x8*)(Bp + rb[bj][n]);
#pragma unroll
            for (int ai = 0; ai < 2; ++ai)
#pragma unroll
                for (int bj = 0; bj < 2; ++bj)
#pragma unroll
                    for (int m = 0; m < 4; ++m)
#pragma unroll
                        for (int n = 0; n < 2; ++n) acc[ai][bj][m][n] = __builtin_amdgcn_mfma_f32_16x16x32_bf16(bv[bj][n], av[ai][m], acc[ai][bj][m][n], 0, 0, 0);
        }
        E.run(acc, u, wr, wc, fr, fq, lds, tid);
    }
}

constexpr int HTB = 128 * 64 * 2;
__device__ __forceinline__ int lds_byte(int r, int c) { const int st = (r >> 4) * 2 + (c >> 5), rr = r & 15, cc = c & 31, ob = rr * 64 + cc * 2; return st * 1024 + (ob ^ (((ob >> 9) & 1) << 5)); }
__device__ __forceinline__ void stage_rc(int b, int& R, int& Cc) { const int st = b / 1024, sb = b % 1024, swz = sb ^ (((sb >> 9) & 1) << 5); R = (st >> 1) * 16 + swz / 64; Cc = (st & 1) * 32 + (swz % 64) / 2; }

template <class Epi, class Sched, bool AFTER_DRAIN>
__device__ __forceinline__ void gemm_pipe(LAS unsigned char* lds, const Sched& S, const Epi& E) {
    const int tid = opaque_tid(), wid = __builtin_amdgcn_readfirstlane(tid >> 6), lane = tid & 63, wr = wid >> 2, wc = wid & 3, fr = lane & 15, fq = lane >> 4;
    constexpr bool ALIGN_EPI = !AFTER_DRAIN;
    int R0, C0, R1, C1; stage_rc(tid * 16, R0, C0); stage_rc(tid * 16 + 8192, R1, C1);
    const int Rb0 = (R0 & ~31) + perm32(R0 & 31), Rb1 = (R1 & ~31) + perm32(R1 & 31);
    const unsigned ldsw = (unsigned)wid * 1024u;
    const int aoff = lds_byte(wr * 64 + fr, fq * 8), boff = lds_byte(wc * 32 + fr, fq * 8);
    GUnit cur, nxt;
    if (!S.next(0, cur)) return;
    unsigned vaC[2][2], vaN[2][2], vbC[2], vbN[2];
#define GP_VOFF(U, va, vb) do { \
        va[0][0] = ((unsigned)unit_row(U, R0) * (unsigned)(U).lda + (unsigned)C0) * 2u; va[0][1] = ((unsigned)unit_row(U, R1) * (unsigned)(U).lda + (unsigned)C1) * 2u; \
        va[1][0] = ((unsigned)unit_row(U, 128 + R0) * (unsigned)(U).lda + (unsigned)C0) * 2u; va[1][1] = ((unsigned)unit_row(U, 128 + R1) * (unsigned)(U).lda + (unsigned)C1) * 2u; \
        vb[0] = ((unsigned)Rb0 * (unsigned)(U).ldb + (unsigned)C0) * 2u; vb[1] = ((unsigned)Rb1 * (unsigned)(U).ldb + (unsigned)C1) * 2u; } while (0)
    GP_VOFF(cur, vaC, vbC);
#define GP_SA(b, h) (((b) * 2 + (h)) * HTB)
#define GP_SB(b, h) ((4 + (b) * 2 + (h)) * HTB)
#define GP_GLDS(gp, off) __builtin_amdgcn_global_load_lds((const unsigned*)(gp), (LAS unsigned*)(lds + (off)), 16, 0, 0)
#define GP_STAGE(bufoff, gbase, v0, v1) do { GP_GLDS((const char*)(gbase) + (v0), (bufoff) + ldsw); GP_GLDS((const char*)(gbase) + (v1), (bufoff) + ldsw + 8192); } while (0)
#define GP_APTR(U, t) ((const char*)(U).A + (size_t)(t) * 128)
#define GP_BPTR(U, t, h) ((const char*)((t) < (U).ksplit ? (U).B0 : (U).B1) + (size_t)(t) * 128 + (size_t)(h) * 256 * (size_t)(U).ldb)
#define GP_LDA(dst, b, h) do { _Pragma("unroll") for (int m = 0; m < 4; ++m) _Pragma("unroll") for (int k = 0; k < 2; ++k) dst[m][k] = *(const LAS bf16x8*)(lds + GP_SA(b, h) + aoff + m * 2048 + k * 1024); } while (0)
#define GP_LDB(dst, b, h) do { _Pragma("unroll") for (int n = 0; n < 2; ++n) _Pragma("unroll") for (int k = 0; k < 2; ++k) dst[n][k] = *(const LAS bf16x8*)(lds + GP_SB(b, h) + boff + n * 2048 + k * 1024); } while (0)
#define GP_MMA(ai, bj, At, Bt) do { __builtin_amdgcn_s_setprio(1); _Pragma("unroll") for (int m = 0; m < 4; ++m) _Pragma("unroll") for (int n = 0; n < 2; ++n) _Pragma("unroll") for (int k = 0; k < 2; ++k) \
        acc[ai][bj][m][n] = __builtin_amdgcn_mfma_f32_16x16x32_bf16(Bt[n][k], At[m][k], acc[ai][bj][m][n], 0, 0, 0); __builtin_amdgcn_s_setprio(0); } while (0)
#define GP_WAIT_V(n) asm volatile("s_waitcnt vmcnt(" #n ")" ::: "memory")
#define GP_WAIT_L(n) asm volatile("s_waitcnt lgkmcnt(" #n ")" ::: "memory")
#define GP_BAR __builtin_amdgcn_s_barrier()
#define GP_SCHED __builtin_amdgcn_sched_barrier(0)
    Acc acc;
#pragma unroll
    for (int a = 0; a < 2; ++a)
#pragma unroll
        for (int b = 0; b < 2; ++b)
#pragma unroll
            for (int m = 0; m < 4; ++m)
#pragma unroll
                for (int n = 0; n < 2; ++n) acc[a][b][m][n] = (f32x4){0.f, 0.f, 0.f, 0.f};
    bf16x8 At[4][2], B0[2][2], B1[2][2];
    GP_STAGE(GP_SB(0, 0), GP_BPTR(cur, 0, 0), vbC[0], vbC[1]); GP_STAGE(GP_SB(0, 1), GP_BPTR(cur, 0, 1), vbC[0], vbC[1]);
    GP_STAGE(GP_SA(0, 0), GP_APTR(cur, 0), vaC[0][0], vaC[0][1]); GP_STAGE(GP_SA(0, 1), GP_APTR(cur, 0), vaC[1][0], vaC[1][1]);
    if (wr == 1) GP_BAR;
    GP_WAIT_V(2); GP_BAR;
    GP_STAGE(GP_SB(1, 0), GP_BPTR(cur, 1, 0), vbC[0], vbC[1]); GP_STAGE(GP_SA(1, 0), GP_APTR(cur, 1), vaC[0][0], vaC[0][1]); GP_STAGE(GP_SB(1, 1), GP_BPTR(cur, 1, 1), vbC[0], vbC[1]);
    GP_WAIT_V(6); GP_BAR;
    int ui = 0;
    for (;;) {
        const bool has_next = S.next(ui + 1, nxt);
        if (has_next) { GP_VOFF(nxt, vaN, vbN); }
        else { nxt = cur; vaN[0][0] = vaC[0][0]; vaN[0][1] = vaC[0][1]; vaN[1][0] = vaC[1][0]; vaN[1][1] = vaC[1][1]; vbN[0] = vbC[0]; vbN[1] = vbC[1]; }
        const int nt = cur.nk;
#pragma unroll 1
        for (int t = 0; t < nt; t += 2) {
            const bool last = (t == nt - 2);
            const char* a2 = last ? GP_APTR(nxt, 0) : GP_APTR(cur, t + 2); const char* a3 = last ? GP_APTR(nxt, 1) : GP_APTR(cur, t + 3);
            const char* b20 = last ? GP_BPTR(nxt, 0, 0) : GP_BPTR(cur, t + 2, 0); const char* b21 = last ? GP_BPTR(nxt, 0, 1) : GP_BPTR(cur, t + 2, 1);
            const char* b30 = last ? GP_BPTR(nxt, 1, 0) : GP_BPTR(cur, t + 3, 0); const char* b31 = last ? GP_BPTR(nxt, 1, 1) : GP_BPTR(cur, t + 3, 1);
            const unsigned xa00 = last ? vaN[0][0] : vaC[0][0], xa01 = last ? vaN[0][1] : vaC[0][1], xa10 = last ? vaN[1][0] : vaC[1][0], xa11 = last ? vaN[1][1] : vaC[1][1];
            const unsigned xb0 = last ? vbN[0] : vbC[0], xb1 = last ? vbN[1] : vbC[1];
            GP_LDB(B0, 0, 0); GP_LDB(B1, 0, 1); GP_SCHED; GP_LDA(At, 0, 0); GP_STAGE(GP_SA(1, 1), GP_APTR(cur, t + 1), vaC[1][0], vaC[1][1]);
            GP_WAIT_V(8); GP_WAIT_L(0); GP_BAR; GP_MMA(0, 0, At, B0); GP_MMA(0, 1, At, B1); GP_BAR; GP_SCHED;
            GP_LDA(At, 0, 1); GP_STAGE(GP_SB(0, 0), b20, xb0, xb1); GP_STAGE(GP_SB(0, 1), b21, xb0, xb1); GP_STAGE(GP_SA(0, 0), a2, xa00, xa01);
            GP_WAIT_V(8); GP_WAIT_L(0); GP_BAR; GP_MMA(1, 0, At, B0); GP_MMA(1, 1, At, B1); GP_BAR; GP_SCHED;
            GP_LDB(B0, 1, 0); GP_LDB(B1, 1, 1); GP_SCHED; GP_LDA(At, 1, 0); GP_STAGE(GP_SA(0, 1), a2, xa10, xa11);
            GP_WAIT_V(8); GP_WAIT_L(0); GP_BAR; GP_MMA(0, 0, At, B0); GP_MMA(0, 1, At, B1); GP_BAR; GP_SCHED;
            GP_LDA(At, 1, 1); GP_STAGE(GP_SB(1, 0), b30, xb0, xb1); GP_STAGE(GP_SB(1, 1), b31, xb0, xb1); GP_STAGE(GP_SA(1, 0), a3, xa00, xa01);
            GP_WAIT_V(8); GP_WAIT_L(0); GP_BAR; GP_MMA(1, 0, At, B0); GP_MMA(1, 1, At, B1); GP_BAR; GP_SCHED;
        }
        if constexpr (ALIGN_EPI) { if (wr == 0) GP_BAR; }
        if constexpr (!AFTER_DRAIN) { E.run(acc, cur, wr, wc, fr, fq, lds, tid); }
        if (!has_next) break;
#pragma unroll
        for (int a = 0; a < 2; ++a)
#pragma unroll
            for (int b = 0; b < 2; ++b)
#pragma unroll
                for (int m = 0; m < 4; ++m)
#pragma unroll
                    for (int n = 0; n < 2; ++n) acc[a][b][m][n] = (f32x4){0.f, 0.f, 0.f, 0.f};
        cur = nxt; vaC[0][0] = vaN[0][0]; vaC[0][1] = vaN[0][1]; vaC[1][0] = vaN[1][0]; vaC[1][1] = vaN[1][1]; vbC[0] = vbN[0]; vbC[1] = vbN[1]; ++ui;
        if constexpr (ALIGN_EPI) { if (wr == 1) GP_BAR; }
    }
    GP_WAIT_V(0);
    if constexpr (!ALIGN_EPI) { if (wr == 0) GP_BAR; }
    GP_BAR;
    if constexpr (AFTER_DRAIN) { E.run(acc, cur, wr, wc, fr, fq, lds, tid); }
#undef GP_VOFF
#undef GP_SA
#undef GP_SB
#undef GP_GLDS
#undef GP_STAGE
#undef GP_APTR
#undef GP_BPTR
#undef GP_LDA
#undef GP_LDB
#undef GP_MMA
#undef GP_WAIT_V
#undef GP_WAIT_L
#undef GP_BAR
#undef GP_SCHED
}

__device__ __forceinline__ void tr_item(const float* W, int N, int k0, int n0, bf16_t* dst  , int ldd, LAS float* scr, int lane) {
#pragma unroll 8
    for (int i = 0; i < 32; ++i) { const int kk = 2 * i + (lane >> 5); scr[kk * 33 + (lane & 31)] = W[(size_t)(k0 + kk) * N + n0 + (lane & 31)]; }
    asm volatile("s_waitcnt lgkmcnt(0)" ::: "memory");
    const int c = lane & 7;
#pragma unroll
    for (int j = 0; j < 4; ++j) { const int n = (lane >> 3) + 8 * j; const LAS float* s = scr + (8 * c) * 33 + n;
        u32x4 o; o.x = cvtpk(s[0 * 33], s[1 * 33]); o.y = cvtpk(s[2 * 33], s[3 * 33]); o.z = cvtpk(s[4 * 33], s[5 * 33]); o.w = cvtpk(s[6 * 33], s[7 * 33]);
        *(u32x4*)(dst + (size_t)n * ldd + 8 * c) = o; }
    asm volatile("s_waitcnt lgkmcnt(0)" ::: "memory");
}

__device__ __forceinline__ void phase_pa(const Ctx& C, LAS unsigned char* lds) {
    const int tid = opaque_tid(), lane = tid & 63, wave = __builtin_amdgcn_readfirstlane(tid >> 6);
    for (int item = blockIdx.x; item < 96; item += C.G) {
        const int l = item / 24, n0 = (item % 24) * 256;
        LAS float* cact = (LAS float*)lds;
        for (int i = tid; i < 16 * 1024; i += NTHR) { const int b = i >> 10, k = i & 1023; const float c = I_c[b * 1024 + k]; cact[k * 16 + b] = silu_f(c); }
        __syncthreads();
        f32x4 acc[16];
#pragma unroll
        for (int b = 0; b < 16; ++b) acc[b] = (f32x4){0.f, 0.f, 0.f, 0.f};
        const float* W = I_w_ada + ((size_t)l * 1024 + wave * 128) * 6144 + n0 + 4 * lane;
#pragma unroll 1
        for (int k = 0; k < 128; k += 4) {
            f32x4 w[4];
#pragma unroll
            for (int j = 0; j < 4; ++j) w[j] = *(const f32x4*)(W + (size_t)(k + j) * 6144);
#pragma unroll
            for (int j = 0; j < 4; ++j) {
                const LAS f32x4* cv = (const LAS f32x4*)(cact + (wave * 128 + k + j) * 16);
#pragma unroll
                for (int q = 0; q < 4; ++q) { const f32x4 cc = cv[q]; acc[4 * q + 0] += cc.x * w[j]; acc[4 * q + 1] += cc.y * w[j]; acc[4 * q + 2] += cc.z * w[j]; acc[4 * q + 3] += cc.w * w[j]; }
            }
        }
        __syncthreads();
        LAS float* red = (LAS float*)lds;
#pragma unroll
        for (int b = 0; b < 16; ++b) *(LAS f32x4*)(red + (wave * 16 + b) * 256 + 4 * lane) = acc[b];
        __syncthreads();
        for (int o = tid; o < 4096; o += NTHR) { const int b = o >> 8, ci = o & 255; float s = 0.f;
#pragma unroll
            for (int w = 0; w < 8; ++w) s += red[(w * 16 + b) * 256 + ci];
            W_MOD[(size_t)(l * 16 + b) * 6144 + n0 + ci] = s + I_b_ada[l * 6144 + n0 + ci]; }
        __syncthreads();
    }
    LAS float* scr = (LAS float*)(lds + wave * 16384);
    const int gw = blockIdx.x * NWAVES + wave, NGW = C.G * NWAVES;
    for (int it = gw; it < 8192 * DEPTH; it += NGW) {
        const int l = it >> 13; int r = it & 8191;
        if (r < 1536) { const int kb = r / 96, nb = r % 96; tr_item(I_w_in + (size_t)l * D * INW, INW, 64 * kb, 32 * nb, W_WIN + ((size_t)l * INW + 32 * nb) * D + 64 * kb, D, scr, lane); continue; }
        r -= 1536;
        if (r < 512) { const int kb = r / 32, nb = r % 32; tr_item(I_w_out + (size_t)l * D * D, D, 64 * kb, 32 * nb, W_WOUT + ((size_t)l * D + 32 * nb) * D + 64 * kb, D, scr, lane); continue; }
        r -= 512;
        if (r < 4096) { const int gu = r >> 11; r &= 2047; const int e = r >> 7, rr = r & 127, kb = rr / 8, nb = rr % 8, n0 = 32 * nb;
            const float* src = (gu ? I_w_up : I_w_gate) + (size_t)(l * 16 + e) * D * FF;
            bf16_t* dst = W_WGU + ((size_t)(((l * 16 + e) * 2 + (n0 >> 7)) * 2 + gu) * 128 + (n0 & 127)) * D + 64 * kb;
            tr_item(src, FF, 64 * kb, n0, dst, D, scr, lane); continue; }
        r -= 4096;
        { const int e = r >> 7, rr = r & 127, kb = rr / 32, nb = rr % 32;
          tr_item(I_w_down + (size_t)(l * 16 + e) * FF * D, D, 64 * kb, 32 * nb, W_WD + ((size_t)(l * 16 + e) * D + 32 * nb) * FF + 64 * kb, FF, scr, lane); }
    }
    const int gt = blockIdx.x * NTHR + tid, NGT = C.G * NTHR;
    for (int i = gt; i < DEPTH * 256 * 1024; i += NGT) {
        const int l = i >> 18, j = (i >> 10) & 255, k = i & 1023; float v = 0.f;
        if (j < 4) v = I_w_rg[((size_t)l * 1024 + k) * 4 + j]; else if (j < 32 && (j & 4)) v = I_w_re[((size_t)l * 1024 + k) * 16 + 4 * (j >> 3) + (j & 3)];
        W_WR[i] = f2bf(v);
    }
}

__device__ __forceinline__ void phase_pa2(const Ctx& C) {
    const int tid = opaque_tid(), lane = tid & 63, wave = __builtin_amdgcn_readfirstlane(tid >> 6);
    const int gt = blockIdx.x * NTHR + tid, NGT = C.G * NTHR;
    for (int i = gt; i < DEPTH * 16 * 1024; i += NGT) {
        const int l = i >> 14, b = (i >> 10) & 15, k = i & 1023; const float* m = W_MOD + (size_t)(l * 16 + b) * 6144;
        W_GM1[i] = I_norm1_g[l * 1024 + k] * (1.f + m[1024 + k]); W_GM2[i] = I_norm2_g[l * 1024 + k] * (1.f + m[4096 + k]);
        W_SH[(size_t)((l * 2 + 0) * 16 + b) * 1024 + k] = f2bf(m[k]); W_SH[(size_t)((l * 2 + 1) * 16 + b) * 1024 + k] = f2bf(m[3072 + k]);
    }
    const int gw = blockIdx.x * NWAVES + wave, NGW = C.G * NWAVES;
    for (int tok = gw; tok < NTOK; tok += NGW) {
        const int b = tok >> 11; const float* xr = I_x + (size_t)tok * D; const float* sc = W_MOD + (size_t)b * 6144 + 1024;
        float ss = 0.f;
#pragma unroll
        for (int j = 0; j < 4; ++j) {
            const int k = 4 * lane + 256 * j; const f32x4 v = *(const f32x4*)(xr + k), g = *(const f32x4*)(I_norm1_g + k), s = *(const f32x4*)(sc + k);
            ss += (v.x * v.x + v.y * v.y) + (v.z * v.z + v.w * v.w);
            const f32x4 o = v * g * (s + 1.f);
            u32x2 w; w.x = cvtpk(o.x, o.y); w.y = cvtpk(o.z, o.w); *(u32x2*)(W_XG + (size_t)tok * D + k) = w;
        }
        ss = wave_sum(ss);
        if (lane < 16) W_PART1[(size_t)tok * 16 + lane] = lane == 0 ? ss : 0.f;
    }
}

__device__ __forceinline__ void phase_t2(const Ctx& C, int l) {
    const int tid = opaque_tid(), lane = tid & 63, gw = blockIdx.x * NWAVES + __builtin_amdgcn_readfirstlane(tid >> 6), NGW = C.G * NWAVES;
    for (int run = gw; run < NTOK / 16; run += NGW) {
        const int t0 = run * 16, ch0 = lane * 8;
        float cw0[8], cw1[8], cw2[8], og[8];
#pragma unroll
        for (int j = 0; j < 8; ++j) { cw0[j] = I_conv_w[(l * 3 + 0) * CW + ch0 + j]; cw1[j] = I_conv_w[(l * 3 + 1) * CW + ch0 + j]; cw2[j] = I_conv_w[(l * 3 + 2) * CW + ch0 + j]; og[j] = I_conv_out_g[l * CW + ch0 + j]; }
        float g1[8], g2[8];
#pragma unroll
        for (int j = 0; j < 8; ++j) { g1[j] = 0.f; g2[j] = 0.f; }
        if ((t0 & (SEQ - 1)) != 0) {
            float a[8], b[8];
            unpack8(*(const u32x4*)(W_UBCH + (size_t)(t0 - 2) * 1536 + 512 + ch0), a); unpack8(*(const u32x4*)(W_UBCH + (size_t)(t0 - 2) * 1536 + 1024 + ch0), b);
#pragma unroll
            for (int j = 0; j < 8; ++j) g2[j] = a[j] * b[j];
            unpack8(*(const u32x4*)(W_UBCH + (size_t)(t0 - 1) * 1536 + 512 + ch0), a); unpack8(*(const u32x4*)(W_UBCH + (size_t)(t0 - 1) * 1536 + 1024 + ch0), b);
#pragma unroll
            for (int j = 0; j < 8; ++j) g1[j] = a[j] * b[j];
        }
#pragma unroll 2
        for (int t = t0; t < t0 + 16; ++t) {
            float ub[8], uc[8], uh[8], y[8];
            const bf16_t* row = W_UBCH + (size_t)t * 1536 + ch0;
            unpack8(*(const u32x4*)(row), ub); unpack8(*(const u32x4*)(row + 512), uc); unpack8(*(const u32x4*)(row + 1024), uh);
            float ss = 0.f;
#pragma unroll
            for (int j = 0; j < 8; ++j) { const float g = uc[j] * uh[j]; y[j] = ub[j] * (cw0[j] * g2[j] + cw1[j] * g1[j] + cw2[j] * g); ss += y[j] * y[j]; g2[j] = g1[j]; g1[j] = g; }
            ss = wave_sum(ss);
            const float r = 1.0f / sqrtf(ss * (1.f / CW) + EPS);
#pragma unroll
            for (int j = 0; j < 8; ++j) y[j] = y[j] * r * og[j];
            *(u32x4*)(W_YMIX + (size_t)t * D + ch0) = pack8(y);
        }
    }
    for (int item = gw; item < 2 * NB * NBLK * NH; item += NGW) {
        const int which = item >> 10, rem = item & 1023, b = rem >> 6, blk = (rem >> 3) & 7, h = rem & 7;
        bf16_t* buf = which ? W_K : W_Q; const float* gn = (which ? I_k_norm_g : I_q_norm_g) + l * HD;
        const int c = lane & 7, rsub = lane >> 3;
        float gv[8], invf[8], ksum[8];
#pragma unroll
        for (int j = 0; j < 8; ++j) { gv[j] = gn[8 * c + j]; invf[j] = exp2f(-(float)(8 * (c & 3) + j) * (13.287712379549449f / 32.f)); ksum[j] = 0.f; }
        const float osc = which ? 1.f : C2;
#pragma unroll 2
        for (int it = 0; it < 32; ++it) {
            const int tok = b * SEQ + blk * 256 + it * 8 + rsub;
            bf16_t* p = buf + (size_t)tok * 512 + h * 64 + 8 * c;
            float x[8]; unpack8(*(const u32x4*)p, x);
            float ss = 0.f;
#pragma unroll
            for (int j = 0; j < 8; ++j) ss += x[j] * x[j];
            ss += __shfl_xor(ss, 1); ss += __shfl_xor(ss, 2); ss += __shfl_xor(ss, 4);
            const float r = 1.0f / sqrtf(ss * (1.f / HD) + EPS);
            const float pf = (float)I_pos[tok];
            float o[8];
#pragma unroll
            for (int j = 0; j < 8; ++j) {
                const float xn = x[j] * r * gv[j]; const float pr = __shfl_xor(xn, 4);
                float rev = pf * invf[j] * 0.15915494309189535f; rev = rev - floorf(rev);
                const float sn = __builtin_amdgcn_sinf(rev), cs = __builtin_amdgcn_cosf(rev);
                o[j] = (c < 4) ? (xn * cs - pr * sn) : (xn * cs + pr * sn);
                if (which) ksum[j] += o[j];
                o[j] *= osc;
            }
            *(u32x4*)p = pack8(o);
        }
        if (which) {
#pragma unroll
            for (int j = 0; j < 8; ++j) { float s = ksum[j]; s += __shfl_xor(s, 8); s += __shfl_xor(s, 16); s += __shfl_xor(s, 32); ksum[j] = s * (1.f / MBLK); }
            if (lane < 8) { float* km = W_KMEAN + ((size_t)((b * NH + h) * NBLK + blk)) * HD + 8 * c;
#pragma unroll
                for (int j = 0; j < 8; ++j) km[j] = ksum[j]; }
        }
    }
}

__device__ __forceinline__ void phase_attn_naive(const Ctx& C) {
    const int tid = opaque_tid(), lane = tid & 63, gw = blockIdx.x * NWAVES + __builtin_amdgcn_readfirstlane(tid >> 6), NGW = C.G * NWAVES;
    for (int item = gw; item < NB * NH * SEQ; item += NGW) {
        const int q = item & (SEQ - 1), h = (item >> 11) & 7, b = item >> 14, own = q >> 8, tok = b * SEQ + q;
        float qv[64];
        { const bf16_t* qp = W_Q + (size_t)tok * 512 + h * 64;
#pragma unroll
          for (int j = 0; j < 8; ++j) { float t[8]; unpack8(*(const u32x4*)(qp + 8 * j), t);
#pragma unroll
              for (int i = 0; i < 8; ++i) qv[8 * j + i] = t[i]; } }
        float gs; { const float* km = W_KMEAN + ((size_t)((b * NH + h) * NBLK + (lane & 7))) * HD; float s = 0.f;
#pragma unroll
            for (int d = 0; d < 64; ++d) s += qv[d] * km[d];
            gs = s; }
        float gsc[8];
#pragma unroll
        for (int j = 0; j < 8; ++j) gsc[j] = (j < own) ? __shfl(gs, j) : -INFINITY;
        unsigned sel = 0; const int nsel = own < 3 ? own : 3;
        for (int s = 0; s < nsel; ++s) { int bi = -1; float bv = -INFINITY;
#pragma unroll
            for (int j = 0; j < 8; ++j) if (j < own && !((sel >> j) & 1u) && (bi < 0 || gsc[j] > bv)) { bv = gsc[j]; bi = j; }
            sel |= 1u << bi; }
        float mrun = -INFINITY, lrun = 0.f, oacc = 0.f;
        for (int jb = 0; jb <= own; ++jb) {
            if (jb < own && !((sel >> jb) & 1u)) continue;
            for (int kk = 0; kk < 4; ++kk) {
                const int key = jb * 256 + kk * 64 + lane; const bf16_t* kp = W_K + (size_t)(b * SEQ + key) * 512 + h * 64;
                float s = 0.f;
#pragma unroll
                for (int j = 0; j < 8; ++j) { float t[8]; unpack8(*(const u32x4*)(kp + 8 * j), t);
#pragma unroll
                    for (int i = 0; i < 8; ++i) s += qv[8 * j + i] * t[i]; }
                if (jb == own && key > q) s = -INFINITY;
                const float cm = wave_max(s);
                if (cm == -INFINITY) continue;
                const float mn = fmaxf(mrun, cm), scl = exp2f(mrun - mn), p = exp2f(s - mn);
                lrun = lrun * scl + wave_sum(p); oacc *= scl; mrun = mn;
                const bf16_t* vp = W_V + (size_t)(b * SEQ + jb * 256 + kk * 64) * 512 + h * 64 + lane;
#pragma unroll 8
                for (int j = 0; j < 64; ++j) { const float pj = __shfl(p, j); oacc += pj * __uint_as_float((unsigned)vp[(size_t)j * 512] << 16); }
            }
        }
        W_YATT[(size_t)tok * 512 + h * 64 + lane] = f2bf(oacc / lrun);
    }
}

namespace attn_body {
typedef unsigned short bf16;
using bf16x8=__attribute__((ext_vector_type(8)))short;
using s16x4=__attribute__((ext_vector_type(4)))short;
using f32x16=__attribute__((ext_vector_type(16)))float;
using u32x4=__attribute__((ext_vector_type(4)))unsigned;
constexpr int BATCH=16,NHEAD=8,SEQ=2048,D=64,DM=NHEAD*D;
constexpr int NW=8,QBLK=32,QB=QBLK*NW,KVBLK=64,NQB=SEQ/QB;
constexpr int ATTN_PITCH=DM, ATTN_UNIT_ROWS=QB;
__device__ __forceinline__ int crow(int r,int hi){return (r&3)+8*(r>>2)+4*hi;}
#define SBAR() __builtin_amdgcn_sched_barrier(0)
__device__ __forceinline__ void cmask(f32x16&p0,f32x16&p1,int jb,int qrel,int hi){
  const float NEG=-INFINITY; int kb=64*jb+4*hi;
  #pragma unroll
  for(int r=0;r<16;++r){int kv=kb+(r&3)+8*(r>>2); if(kv>qrel)p0[r]=NEG; if(kv+32>qrel)p1[r]=NEG;}
}

constexpr int NSLOT=3, SLOTB=8192;
constexpr int LDS_K=0, LDS_V=NSLOT*SLOTB, LDS_WS=2*NSLOT*SLOTB, LDS_OST=LDS_WS+NW*64*4, LDS_BYTES=LDS_OST+NW*4096;
constexpr float C2=0.125f*1.4426950408889634f;
__device__ __forceinline__ void glds16(const void*gsrc,unsigned lds_dst){unsigned keep;
  asm volatile("s_mov_b32 %0, m0\n\ts_mov_b32 m0, %2\n\ts_nop 0\n\tglobal_load_lds_dwordx4 %1, off\n\ts_mov_b32 m0, %0":"=&s"(keep):"v"(gsrc),"s"(lds_dst):"memory");}
__device__ __forceinline__ float max3f(float a,float b,float c){float r;asm("v_max3_f32 %0, %1, %2, %3":"=v"(r):"v"(a),"v"(b),"v"(c));return r;}
__device__ __forceinline__ float max2f(float a,float b){float r;asm("v_max_f32_e32 %0, %1, %2":"=v"(r):"v"(a),"v"(b));return r;}
__device__ __forceinline__ float fadd_s(float a,float b){float r;asm("v_add_f32_e32 %0, %1, %2":"=v"(r):"v"(a),"v"(b));return r;}
__device__ __forceinline__ float fsub_s(float a,float b){float r;asm("v_sub_f32_e32 %0, %1, %2":"=v"(r):"v"(a),"v"(b));return r;}
typedef float f32x2_t __attribute__((ext_vector_type(2))); typedef __bf16 bf16x2_t __attribute__((ext_vector_type(2)));
__device__ __forceinline__ unsigned cvtpk_s(float lo,float hi){f32x2_t v={lo,hi};bf16x2_t b=__builtin_convertvector(v,bf16x2_t);return __builtin_bit_cast(unsigned,b);}
#define WAIT_BAR(N) asm volatile("s_waitcnt vmcnt(" #N ") lgkmcnt(0)\n\ts_barrier":::"memory")

__device__ __forceinline__ void qkt(f32x16&p0,f32x16&p1,const char*Kslot,const bf16x8*qr,const f32x16&negm,int r32,int hi){
  const char*kb=Kslot+hi*1024+r32*16;
  #pragma unroll
  for(int d0=0;d0<4;++d0){
    const bf16x8 b0=*reinterpret_cast<const bf16x8*>(kb+d0*2048);
    const bf16x8 b1=*reinterpret_cast<const bf16x8*>(kb+d0*2048+512);
    if(d0==0){p0=__builtin_amdgcn_mfma_f32_32x32x16_bf16(b0,qr[0],negm,0,0,0);p1=__builtin_amdgcn_mfma_f32_32x32x16_bf16(b1,qr[0],negm,0,0,0);}
    else{p0=__builtin_amdgcn_mfma_f32_32x32x16_bf16(b0,qr[d0],p0,0,0,0);p1=__builtin_amdgcn_mfma_f32_32x32x16_bf16(b1,qr[d0],p1,0,0,0);}}
}
typedef __attribute__((address_space(3))) const char* lds_cptr;
typedef short v4i16_t __attribute__((ext_vector_type(4)));
__device__ __forceinline__ void kload8(bf16x8*kf,lds_cptr kp){
  kf[0]=*(const __attribute__((address_space(3))) bf16x8*)(kp);      kf[1]=*(const __attribute__((address_space(3))) bf16x8*)(kp+512);
  kf[2]=*(const __attribute__((address_space(3))) bf16x8*)(kp+2048); kf[3]=*(const __attribute__((address_space(3))) bf16x8*)(kp+2560);
  kf[4]=*(const __attribute__((address_space(3))) bf16x8*)(kp+4096); kf[5]=*(const __attribute__((address_space(3))) bf16x8*)(kp+4608);
  kf[6]=*(const __attribute__((address_space(3))) bf16x8*)(kp+6144); kf[7]=*(const __attribute__((address_space(3))) bf16x8*)(kp+6656);
}
__device__ __forceinline__ void kload2(bf16x8*kf,lds_cptr kp,int j){ kf[2*j]=*(const __attribute__((address_space(3))) bf16x8*)(kp+j*2048); kf[2*j+1]=*(const __attribute__((address_space(3))) bf16x8*)(kp+j*2048+512); }
__device__ __forceinline__ s16x4 vtr(lds_cptr p){ return __builtin_bit_cast(s16x4,__builtin_amdgcn_ds_read_tr16_b64_v4i16((__attribute__((address_space(3))) v4i16_t*)p)); }
__device__ __forceinline__ float rowmax(const f32x16&p0,const f32x16&p1){
  float a=max3f(p0[0],p0[1],p1[0]),b=max3f(p0[2],p0[3],p1[1]);a=max3f(a,p1[2],p1[3]);
  #pragma unroll
  for(int r=4;r<16;r+=4){a=max3f(a,p0[r],p0[r+1]);b=max3f(b,p0[r+2],p0[r+3]);a=max3f(a,p1[r],p1[r+1]);b=max3f(b,p1[r+2],p1[r+3]);}
  const float m=max2f(a,b);
  auto rr=__builtin_amdgcn_permlane32_swap(__float_as_uint(m),__float_as_uint(m),false,false);
  return max2f(__uint_as_float(rr[0]),__uint_as_float(rr[1]));
}
__device__ __forceinline__ void pv(f32x16*o,int vb,bf16x8 pa0,bf16x8 pa1,bf16x8 pa2,bf16x8 pa3){
  #pragma unroll
  for(int d0=0;d0<2;++d0){s16x4 lo[4],hi[4];
    #pragma unroll
    for(int ks=0;ks<4;++ks){
      asm volatile("ds_read_b64_tr_b16 %0,%1 offset:%c2":"=&v"(lo[ks]):"v"(vb),"i"(d0*4096+ks*1024):"memory");
      asm volatile("ds_read_b64_tr_b16 %0,%1 offset:%c2":"=&v"(hi[ks]):"v"(vb),"i"(d0*4096+ks*1024+512):"memory");}
    asm volatile("s_waitcnt lgkmcnt(0)":::"memory");SBAR();
    #define PK(k) (bf16x8){lo[k][0],lo[k][1],lo[k][2],lo[k][3],hi[k][0],hi[k][1],hi[k][2],hi[k][3]}
    o[d0]=__builtin_amdgcn_mfma_f32_32x32x16_bf16(pa0,PK(0),o[d0],0,0,0);
    o[d0]=__builtin_amdgcn_mfma_f32_32x32x16_bf16(pa1,PK(1),o[d0],0,0,0);
    o[d0]=__builtin_amdgcn_mfma_f32_32x32x16_bf16(pa2,PK(2),o[d0],0,0,0);
    o[d0]=__builtin_amdgcn_mfma_f32_32x32x16_bf16(pa3,PK(3),o[d0],0,0,0);
    #undef PK
  }
}

#ifndef ATTN_STORE16
#define ATTN_STORE16(p,v) (*(u32x4*)(p)=(v))
#endif
template<int THRL> __device__ __forceinline__ void attn_unit(int b,int h,int qb,const bf16*Q,const bf16*__restrict__ K,const bf16*__restrict__ V,bf16*O,const float*__restrict__ KM,char*shm){
  int tid_=threadIdx.x; asm volatile("":"+v"(tid_));
  const int tid=tid_,lane=tid&63,r32=lane&31,hi=lane>>5; const int wid=__builtin_amdgcn_readfirstlane(tid>>6);
  const long rowbase=(long)b*SEQ; const int q0=qb*QB;
  const bf16*Qw=Q+(rowbase+q0+wid*QBLK)*DM+h*D;
  const bf16*Kh=K+rowbase*DM+h*D,*Vh=V+rowbase*DM+h*D;
  const unsigned lds0=(unsigned)(uintptr_t)shm;
  float*wsf=(float*)(shm+LDS_WS)+wid*64;
  const bf16*ksrc=Kh+(long)lane*DM+wid*8;
  const bf16*vsrc=Vh+(long)(16*(wid&3)+(lane>>2))*DM+(wid>>2)*32+(lane&3)*8;
  const unsigned kdst=lds0+LDS_K+wid*1024, vdst=lds0+LDS_V+wid*1024;
  #define KT(t) (((t)<4)?(4*qb+(t)):((t)-4))
  #define DMA_K(t,slot) glds16(ksrc+(long)KT(t)*KVBLK*DM,(unsigned)__builtin_amdgcn_readfirstlane(kdst+(slot)))
  #define DMA_V(t,slot) glds16(vsrc+(long)KT(t)*KVBLK*DM,(unsigned)__builtin_amdgcn_readfirstlane(vdst+(slot)))
  const int vb0=(int)(lds0+LDS_V)+((lane>>4)&1)*32+(lane&3)*8+(4*hi+((lane&15)>>2))*64;
  const char*Kbase=shm+LDS_K; bf16x8 kf[8];
  const lds_cptr shm3=(lds_cptr)shm; const lds_cptr kp0=shm3+LDS_K+hi*1024+r32*16; const lds_cptr vp0=shm3+LDS_V+((lane>>4)&1)*32+(lane&3)*8+(4*hi+((lane&15)>>2))*64;
  const int NT=(q0+QB)/KVBLK;
  DMA_K(0,0);DMA_V(0,0);DMA_K(1,SLOTB);
  bf16x8 qr[4];
  #pragma unroll
  for(int d0=0;d0<4;++d0)qr[d0]=*reinterpret_cast<const bf16x8*>(&Qw[(long)r32*DM+d0*16+hi*8]);
  unsigned selm=0u;
  { float gs[7];
    #pragma unroll
    for(int j=0;j<7;++j){ float s=0.f;
      if(j<qb){ const float*km=KM+j*64+hi*8;
        #pragma unroll
        for(int d0=0;d0<4;++d0){ const float4 k0=*reinterpret_cast<const float4*>(km+d0*16), k1=*reinterpret_cast<const float4*>(km+d0*16+4); const bf16x8 qq=qr[d0];
          s+=__uint_as_float(((unsigned)(unsigned short)qq[0])<<16)*k0.x+__uint_as_float(((unsigned)(unsigned short)qq[1])<<16)*k0.y+__uint_as_float(((unsigned)(unsigned short)qq[2])<<16)*k0.z+__uint_as_float(((unsigned)(unsigned short)qq[3])<<16)*k0.w
            +__uint_as_float(((unsigned)(unsigned short)qq[4])<<16)*k1.x+__uint_as_float(((unsigned)(unsigned short)qq[5])<<16)*k1.y+__uint_as_float(((unsigned)(unsigned short)qq[6])<<16)*k1.z+__uint_as_float(((unsigned)(unsigned short)qq[7])<<16)*k1.w; }
        s=s+__shfl_xor(s,32); }
      gs[j]=s; }
    if(qb<=3) selm=(1u<<qb)-1u;
    else{
      #pragma unroll
      for(int p=0;p<3;++p){ float best=-INFINITY; int bi=0;
        #pragma unroll
        for(int j=0;j<7;++j){ const bool ok=(j<qb)&&!((selm>>j)&1u)&&(gs[j]>best); best=ok?gs[j]:best; bi=ok?j:bi; }
        selm|=1u<<bi; } } }
  float mhat=0.f,l_reg=0.f,negm1=0.f;f32x16 o[2];o[0]=f32x16{};o[1]=f32x16{};
  const int qrel=wid*QBLK+r32;
  #define CMASK(P0,P1,t) do{const int t_=(t); if(t_<4){cmask(P0,P1,t_,qrel,hi);} }while(0)
  bool resc=false;
  #define START(P0,P1) do{ const float rm=rowmax(P0,P1); resc=false; \
    { const float dl=rm; mhat=fadd_s(mhat,dl); \
      _Pragma("unroll") for(int r=0;r<16;++r){P0[r]=fsub_s(P0[r],dl);P1[r]=fsub_s(P1[r],dl);} \
      negm1=-mhat; } \
    _Pragma("unroll") for(int r=0;r<16;++r)P0[r]=__builtin_amdgcn_exp2f(P0[r]); }while(0)
  #define RESC() do{ if(resc){ asm volatile("s_waitcnt lgkmcnt(0)":::"memory"); \
      _Pragma("unroll") for(int d_=0;d_<2;++d_) _Pragma("unroll") for(int r=0;r<16;++r)o[d_][r]*=wsf[crow(r,hi)]; } }while(0)
  f32x16 pA0,pA1,pB0,pB1;
  int sl_prev=0,sl_cur=0,sl_next=SLOTB;
  #define ROT() do{sl_prev=sl_cur;sl_cur=sl_next;sl_next=(sl_next==(NSLOT-1)*SLOTB)?0:sl_next+SLOTB;}while(0)
  DMA_K(2,2*SLOTB);
  WAIT_BAR(3);
  qkt(pA0,pA1,Kbase,qr,f32x16{},r32,hi);asm volatile("s_nop 15\n\ts_nop 7":"+v"(pA0),"+v"(pA1));CMASK(pA0,pA1,0);
  START(pA0,pA1);
  _Pragma("unroll") for(int r=0;r<16;++r)pA1[r]=__builtin_amdgcn_exp2f(pA1[r]);
  WAIT_BAR(0);
  DMA_K(3,0);DMA_V(1,SLOTB);
  ROT();
  kload8(kf,kp0+sl_cur);
  WAIT_BAR(2);
  s16x4 vlo[8],vhi[8]; u32x4 pw0,pw1,pw2,pw3;
  #define PKW(P,B) cvtpk_s(P[B],P[B+1])
  #define PAF(k) __builtin_bit_cast(bf16x8,pw##k)
  #define VFR(i) (bf16x8){vlo[i][0],vlo[i][1],vlo[i][2],vlo[i][3],vhi[i][0],vhi[i][1],vhi[i][2],vhi[i][3]}
  #define PIN(x) asm volatile("":"+v"(x))
  #define MX3(a,b,c) __builtin_fmaxf(__builtin_fmaxf((a),(b)),(c))
  #define GAPA(MF,A0,A1,A2,A3,W0,W1,PW) do{ MF; sacc+=A0; sacc+=A1; sacc+=A2; sacc+=A3; PIN(sacc); W0; W1; PIN(PW); SBAR(); }while(0)
  #define EX(v) __builtin_amdgcn_exp2f(v)
  #define GAPB(MF,X,B) do{ MF; X[B]=EX(X[B]); X[B+1]=EX(X[B+1]); X[B+2]=EX(X[B+2]); X[B+3]=EX(X[B+3]); PIN(X); SBAR(); }while(0)
  #define VRD(i) do{ vlo[i]=vtr(vp_+(((i)>>2)*4096+((i)&3)*1024)); vhi[i]=vtr(vp_+(((i)>>2)*4096+((i)&3)*1024+512)); }while(0)
  #define KRD(G,j) do{ if(G){ kload2(kf,kp0+sl_next,j); SBAR(); } }while(0)
  #define STEP(C0,C1,P0,P1,t,GK,GV,GL) do{ SBAR(); \
    const lds_cptr vp_=vp0+sl_prev; \
    const float cv_=(((t)<4)||((selm>>(((t)-4)>>2))&1u))?negm1:-INFINITY; _Pragma("unroll") for(int r=0;r<16;++r){C0[r]=cv_;C1[r]=cv_;} PIN(C0); PIN(C1); \
    VRD(0); SBAR(); float sacc=(P0[0]+P0[1]); \
    GAPA(C0=__builtin_amdgcn_mfma_f32_32x32x16_bf16(kf[0],qr[0],C0,0,0,0), P0[2],P0[3],P0[4],P0[5],     pw0[0]=PKW(P0,0), pw0[1]=PKW(P0,2), pw0); \
    VRD(4); SBAR(); GAPA(C1=__builtin_amdgcn_mfma_f32_32x32x16_bf16(kf[1],qr[0],C1,0,0,0), P0[6],P0[7],P0[8],P0[9],     pw0[2]=PKW(P0,4), pw0[3]=PKW(P0,6), pw0); \
    VRD(1); SBAR(); GAPA(C0=__builtin_amdgcn_mfma_f32_32x32x16_bf16(kf[2],qr[1],C0,0,0,0),   P0[10],P0[11],P0[12],P0[13], pw1[0]=PKW(P0,8), pw1[1]=PKW(P0,10), pw1); \
    VRD(5); SBAR(); GAPA(C1=__builtin_amdgcn_mfma_f32_32x32x16_bf16(kf[3],qr[1],C1,0,0,0),   P0[14],P0[15],P1[0],P1[1],   pw1[2]=PKW(P0,12),pw1[3]=PKW(P0,14), pw1); \
    VRD(2); SBAR(); GAPA(C0=__builtin_amdgcn_mfma_f32_32x32x16_bf16(kf[4],qr[2],C0,0,0,0),   P1[2],P1[3],P1[4],P1[5],     pw2[0]=PKW(P1,0), pw2[1]=PKW(P1,2), pw2); \
    VRD(6); SBAR(); GAPA(C1=__builtin_amdgcn_mfma_f32_32x32x16_bf16(kf[5],qr[2],C1,0,0,0),   P1[6],P1[7],P1[8],P1[9],     pw2[2]=PKW(P1,4), pw2[3]=PKW(P1,6), pw2); \
    VRD(3); SBAR(); GAPA(C0=__builtin_amdgcn_mfma_f32_32x32x16_bf16(kf[6],qr[3],C0,0,0,0),   P1[10],P1[11],P1[12],P1[13], pw3[0]=PKW(P1,8), pw3[1]=PKW(P1,10), pw3); \
    VRD(7); SBAR(); GAPA(C1=__builtin_amdgcn_mfma_f32_32x32x16_bf16(kf[7],qr[3],C1,0,0,0),   P1[14],P1[15],0.f,0.f,       pw3[2]=PKW(P1,12),pw3[3]=PKW(P1,14), pw3); \
    l_reg+=sacc; \
    if(GK){DMA_K((t)+3,sl_cur);} if(GV){DMA_V((t)+1,sl_next);} \
    CMASK(C0,C1,t); \
    { float a=MX3(C0[0],C0[1],C1[0]),b=MX3(C0[2],C0[3],C1[1]); a=MX3(a,C1[2],C1[3]); \
      _Pragma("unroll") for(int r=4;r<16;r+=4){a=MX3(a,C0[r],C0[r+1]);b=MX3(b,C0[r+2],C0[r+3]);a=MX3(a,C1[r],C1[r+1]);b=MX3(b,C1[r+2],C1[r+3]);} \
      float rm=__builtin_fmaxf(a,b); { auto rr=__builtin_amdgcn_permlane32_swap(__float_as_uint(rm),__float_as_uint(rm),false,false); rm=__builtin_fmaxf(__uint_as_float(rr[0]),__uint_as_float(rr[1])); } \
      resc=false; \
      if(__builtin_expect(__any(rm>(float)THRL),0)){ const float dl=__builtin_fmaxf(rm,0.f); mhat+=dl; \
        _Pragma("unroll") for(int r=0;r<16;++r){C0[r]-=dl;C1[r]-=dl;} \
        negm1=-mhat; \
        const float f=__builtin_amdgcn_exp2f(-dl); l_reg*=f; if(hi==0)wsf[r32]=f; resc=true; } } \
    SBAR(); \
    GAPB(o[0]=__builtin_amdgcn_mfma_f32_32x32x16_bf16(PAF(0),VFR(0),o[0],0,0,0), C0,0); \
    GAPB(o[1]=__builtin_amdgcn_mfma_f32_32x32x16_bf16(PAF(0),VFR(4),o[1],0,0,0), C0,4); \
    KRD(GL,0); GAPB(o[0]=__builtin_amdgcn_mfma_f32_32x32x16_bf16(PAF(1),VFR(1),o[0],0,0,0), C0,8); \
    KRD(GL,1); GAPB(o[1]=__builtin_amdgcn_mfma_f32_32x32x16_bf16(PAF(1),VFR(5),o[1],0,0,0), C0,12); \
    KRD(GL,2); GAPB(o[0]=__builtin_amdgcn_mfma_f32_32x32x16_bf16(PAF(2),VFR(2),o[0],0,0,0), C1,0); \
    KRD(GL,3); GAPB(o[1]=__builtin_amdgcn_mfma_f32_32x32x16_bf16(PAF(2),VFR(6),o[1],0,0,0), C1,4); \
    GAPB(o[0]=__builtin_amdgcn_mfma_f32_32x32x16_bf16(PAF(3),VFR(3),o[0],0,0,0), C1,8); \
    GAPB(o[1]=__builtin_amdgcn_mfma_f32_32x32x16_bf16(PAF(3),VFR(7),o[1],0,0,0), C1,12); \
    }while(0)
  int t=1;
  for(;t+5<NT;t+=2){
    STEP(pB0,pB1,pA0,pA1,t,true,true,true);     WAIT_BAR(2); RESC(); ROT();
    STEP(pA0,pA1,pB0,pB1,t+1,true,true,true);   WAIT_BAR(2); RESC(); ROT();
  }
  #define ENDW(tt) do{ if((tt)+3<NT){WAIT_BAR(2);} else if((tt)+2<NT){WAIT_BAR(1);} else {WAIT_BAR(0);} }while(0)
  for(;t+1<NT;t+=2){
    STEP(pB0,pB1,pA0,pA1,t,(t+3<NT),(t+1<NT),(t+1<NT));       ENDW(t);   RESC(); ROT();
    STEP(pA0,pA1,pB0,pB1,t+1,(t+4<NT),(t+2<NT),(t+2<NT));     ENDW(t+1); RESC(); ROT();
  }
  STEP(pB0,pB1,pA0,pA1,NT-1,false,false,false); RESC();
  { float sacc=pB0[0]+pB0[1]; _Pragma("unroll") for(int r=2;r<16;++r)sacc+=pB0[r]; _Pragma("unroll") for(int r=0;r<16;++r)sacc+=pB1[r]; l_reg+=sacc;
    pw0=(u32x4){PKW(pB0,0),PKW(pB0,2),PKW(pB0,4),PKW(pB0,6)};pw1=(u32x4){PKW(pB0,8),PKW(pB0,10),PKW(pB0,12),PKW(pB0,14)};pw2=(u32x4){PKW(pB1,0),PKW(pB1,2),PKW(pB1,4),PKW(pB1,6)};pw3=(u32x4){PKW(pB1,8),PKW(pB1,10),PKW(pB1,12),PKW(pB1,14)};
    SBAR(); pv(o,vb0+sl_cur,PAF(0),PAF(1),PAF(2),PAF(3)); }
  #undef PKW
  #undef PAF
  #undef VFR
  #undef PIN
  #undef MX3
  #undef GAPA
  #undef GAPB
  #undef EX
  #undef VRD
  #undef KRD
  #undef STEP
  #undef ENDW
  {auto rr=__builtin_amdgcn_permlane32_swap(__float_as_uint(l_reg),__float_as_uint(l_reg),false,false);l_reg=__uint_as_float(rr[0])+__uint_as_float(rr[1]);}
  if(hi==0)wsf[32+r32]=l_reg;asm volatile("s_waitcnt lgkmcnt(0)":::"memory");
  float rli[16];
  #pragma unroll
  for(int r=0;r<16;++r)rli[r]=__builtin_amdgcn_rcpf(wsf[32+crow(r,hi)]);
  bf16*Ow=O+(rowbase+q0+wid*QBLK)*DM+h*D;
  { bf16*stg=(bf16*)(shm+LDS_OST)+wid*2048;
    #pragma unroll
    for(int r=0;r<16;++r){const int orow=crow(r,hi);
      #pragma unroll
      for(int d0=0;d0<2;++d0)stg[orow*64+d0*32+r32]=(bf16)(cvtpk_s(o[d0][r]*rli[r],0.f)&0xffffu);}
    asm volatile("s_waitcnt lgkmcnt(0)":::"memory");
    #pragma unroll
    for(int i=0;i<4;++i){const int row=i*8+(lane>>3),ch=lane&7; const u32x4 v=*(const u32x4*)(stg+row*64+ch*8); ATTN_STORE16(Ow+(long)row*DM+ch*8,v);} }
  asm volatile("s_waitcnt lgkmcnt(0)\n\ts_barrier":::"memory");
  #undef DMA_K
  #undef KT
  #undef DMA_V
  #undef CMASK
  #undef START
  #undef RESC
  #undef ROT
}
constexpr int ATTN_LDS_BYTES=LDS_BYTES;
template<int THRL=8> __device__ __forceinline__ void attn_phase(char*lds,const bf16*Q,const bf16*K,const bf16*V,bf16*O,const float*KMEAN,int vcu,int G){
  for(int slot=vcu;slot<BATCH*NHEAD*2;slot+=G){ const int bh=slot>>1,s=slot&1;
    #pragma unroll 1
    for(int i=0;i<4;++i){ const int qb=(i==0)?(7-s):(i==1)?(5-s):(i==2)?(2+s):s;
      attn_unit<THRL>(bh/NHEAD,bh%NHEAD,qb,Q,K,V,O,KMEAN+(long)bh*(SEQ/QB)*D,lds); } }
}
#undef SBAR
#undef WAIT_BAR
}

__device__ __forceinline__ void phase_t3(const Ctx& C, int l) {
    const int tid = opaque_tid(), lane = tid & 63, gw = blockIdx.x * NWAVES + __builtin_amdgcn_readfirstlane(tid >> 6), NGW = C.G * NWAVES;
    for (int tok = gw; tok < NTOK; tok += NGW) {
        float x[8]; unpack8(*(const u32x4*)(W_YATT + (size_t)tok * 512 + 8 * lane), x);
        float ss = 0.f;
#pragma unroll
        for (int j = 0; j < 8; ++j) ss += x[j] * x[j];
        ss = wave_sum(ss);
        const float r = 1.0f / sqrtf(ss * (1.f / AW) + EPS);
#pragma unroll
        for (int j = 0; j < 8; ++j) x[j] = x[j] * r * I_attn_out_g[l * AW + 8 * lane + j];
        *(u32x4*)(W_YMIX + (size_t)tok * D + 512 + 8 * lane) = pack8(x);
    }
}

__global__ void __launch_bounds__(NTHR, 2) fwd_kernel(Args args) {
    extern __shared__ __attribute__((aligned(16))) unsigned char lds_raw[];
    LAS unsigned char* lds = (LAS unsigned char*)lds_raw;
    Ctx C;
    C.a = &args; C.ws = args.ws; C.out = args.out;
    C.G = gridDim.x; C.tid = threadIdx.x; C.lane = C.tid & 63; C.wave = __builtin_amdgcn_readfirstlane(C.tid >> 6);
    { const int bx = blockIdx.x; C.vcu = (C.G % 8 == 0) ? (bx % 8) * (C.G / 8) + bx / 8 : bx; }

    volatile LAS unsigned* MISC = (volatile LAS unsigned*)(lds + MISC_OFF);
    for (int u = C.tid; u < (LDS_BYTES - MISC_OFF) / 4; u += NTHR) ((LAS unsigned*)(lds + MISC_OFF))[u] = 0u;
    __syncthreads();
    const int lo = args.ph_lo, hi = args.ph_hi;
    XcdBarrier bar; bar.bar = W_ctl + CW_BAR; bar.x = 0; bar.st = nullptr;
    if (hi - lo > 1) bar = xcd_barrier_post(W_ctl + CW_BAR, MISC + 8);
#ifndef PHM
#define PHM 0x7ff
#endif
#ifndef GPM
#define GPM 0x7ff
#endif
#define IN(k) (lo <= (k) && (k) < hi)
#define SEAM(k) do { if (IN(k) && IN((k) + 1)) xcd_barrier(bar); } while (0)

    if ((PHM & 1) && IN(0)) { phase_pa(C, lds); } SEAM(0);
    if ((PHM & 2) && IN(1)) { phase_pa2(C); } SEAM(1);
    if ((PHM & 4) && IN(2)) { SchedBias S{C, C.G, (int)blockIdx.x}; EpiBias E{C}; if (GPM & 4) gemm_pipe<EpiBias, SchedBias, false>(lds, S, E); else gemm_simple(lds, S, E); } SEAM(2);

#pragma unroll 1
    for (int l = 0; l < DEPTH; ++l) {
        const int pb = 3 + 8 * l;
        if ((PHM & 8) && IN(pb + 0)) { SchedDense S{W_XG, W_WIN + (size_t)l * INW * D, NTOK / 256, INW / 256, D, C.G, (int)blockIdx.x}; EpiG1 E{C, l}; if (GPM & 8) gemm_pipe<EpiG1, SchedDense, false>(lds, S, E); else gemm_simple(lds, S, E); } SEAM(pb + 0);
        if ((PHM & 16) && IN(pb + 1)) { phase_t2(C, l); } SEAM(pb + 1);
        #ifndef ATTN_NAIVE
        if ((PHM & 32) && IN(pb + 2)) { attn_body::attn_phase<8>((char*)lds_raw, W_Q, W_K, W_V, W_YATT, W_KMEAN, C.vcu, C.G); }
#else
        if ((PHM & 32) && IN(pb + 2)) { phase_attn_naive(C); }
#endif
        SEAM(pb + 2);
        if ((PHM & 64) && IN(pb + 3)) { phase_t3(C, l); } SEAM(pb + 3);
        if ((PHM & 128) && IN(pb + 4)) { SchedDense S{W_YMIX, W_WOUT + (size_t)l * D * D, NTOK / 256, D / 256, D, C.G, (int)blockIdx.x}; EpiG2 E{C, l}; if (GPM & 128) gemm_pipe<EpiG2, SchedDense, false>(lds, S, E); else gemm_simple(lds, S, E); } SEAM(pb + 4);
        if ((PHM & 256) && IN(pb + 5)) { SchedDense S{W_XG, W_WR + (size_t)l * 256 * D, NTOK / 256, 1, D, C.G, (int)blockIdx.x}; EpiR E{C, l}; if ((GPM & 256) && C.G >= NTOK / 256) gemm_pipe<EpiR, SchedDense, true>(lds, S, E); else gemm_simple(lds, S, E); } SEAM(pb + 5);
        if (IN(pb + 6) || IN(pb + 7)) {
            LAS int* tb = (LAS int*)(lds + MISC_OFF + 256); LAS int* cn = tb + 32;
            __syncthreads();
            if (C.tid == 0) { int acc = 0;
                for (int k = 0; k < NCLS; ++k) { const int cnt = (int)__hip_atomic_load(W_ctl + CW_CNT + l * 2048 + k * 64, __ATOMIC_RELAXED, __HIP_MEMORY_SCOPE_AGENT); tb[k] = acc; cn[k] = cnt; acc += (cnt + 255) >> 8; }
                tb[NCLS] = acc; }
            __syncthreads();
            if ((PHM & 512) && IN(pb + 6)) { SchedMoe S{C, l, C.G, (int)blockIdx.x, tb, cn, false}; EpiG3 E{C, l}; if (GPM & 512) gemm_pipe<EpiG3, SchedMoe, false>(lds, S, E); else gemm_simple(lds, S, E); } SEAM(pb + 6);
            if ((PHM & 1024) && IN(pb + 7)) { SchedMoe S{C, l, C.G, (int)blockIdx.x, tb, cn, true}; EpiG4 E{C, l}; if (GPM & 1024) gemm_pipe<EpiG4, SchedMoe, false>(lds, S, E); else gemm_simple(lds, S, E); } SEAM(pb + 7);
        }
    }
#undef IN
#undef SEAM
}

extern "C" void kernel_launch(void* const* d_in, const int* in_sizes, int n_in, void* d_out, int out_size, void* d_ws, size_t ws_size, hipStream_t stream) {
    static int grid = 0;
    if (grid == 0) {
        if (n_in != 21 || out_size != NTOK * D || ws_size < WS_END) { fprintf(stderr, "kernel_launch: unexpected problem shape (n_in %d, out %d, ws %zu)\n", n_in, out_size, ws_size); grid = -1; return; }
        int dev = 0, cus = 0, per_cu = 0;
        if (hipGetDevice(&dev) != hipSuccess || hipDeviceGetAttribute(&cus, hipDeviceAttributeMultiprocessorCount, dev) != hipSuccess) { grid = -1; return; }
        if (hipFuncSetAttribute((const void*)fwd_kernel, hipFuncAttributeMaxDynamicSharedMemorySize, LDS_BYTES) != hipSuccess) { fprintf(stderr, "kernel_launch: hipFuncSetAttribute failed\n"); grid = -1; return; }
        if (hipOccupancyMaxActiveBlocksPerMultiprocessor(&per_cu, (const void*)fwd_kernel, NTHR, LDS_BYTES) != hipSuccess || per_cu < 1) { fprintf(stderr, "kernel_launch: occupancy query reports %d\n", per_cu); }
        (void)hipGetLastError();
        grid = cus;
    }
    if (grid < 0) return;
    (void)hipMemsetAsync((char*)d_ws + WS_CTL, 0, CTL_ZERO_BYTES, stream);
    Args a{};
    for (int i = 0; i < 21; ++i) a.in[i] = d_in[i];
    a.out = (float*)d_out; a.ws = (unsigned char*)d_ws;
#if MK_ONE_LAUNCH
    a.ph_lo = 0; a.ph_hi = NPHASE;
    hipLaunchKernelGGL(fwd_kernel, dim3(grid), dim3(NTHR), LDS_BYTES, stream, a);
#else
    for (int ph = 0; ph < NPHASE; ++ph) { a.ph_lo = ph; a.ph_hi = ph + 1; hipLaunchKernelGGL(fwd_kernel, dim3(grid), dim3(NTHR), LDS_BYTES, stream, a); }
#endif
}
```

```cpp
#include <hip/hip_runtime.h>
#include <cstdio>
#include <cstdint>

#define LAS __attribute__((address_space(3)))
#define GAS __attribute__((address_space(1)))
typedef unsigned short bf16_t;
typedef short bf16x8 __attribute__((ext_vector_type(8)));
typedef float f32x4 __attribute__((ext_vector_type(4)));
typedef float f32x2 __attribute__((ext_vector_type(2)));
typedef unsigned u32x4 __attribute__((ext_vector_type(4)));
typedef unsigned u32x2 __attribute__((ext_vector_type(2)));
typedef __bf16 bf16x2_t __attribute__((ext_vector_type(2)));

#ifndef MK_ONE_LAUNCH
#define MK_ONE_LAUNCH 1
#endif

constexpr int D = 1024, NB = 16, SEQ = 2048, DEPTH = 4, NTOK = NB * SEQ;
constexpr int CW = 512, AW = 512, NH = 8, HD = 64, INW = 3072, MBLK = 256, NBLK = SEQ / MBLK;
constexpr int NE = 16, FF = 256, NCLS = 24;
constexpr float EPS = 1e-6f;
constexpr float C2 = 0.125f * 1.4426950408889634f;
constexpr int NWAVES = 8, NTHR = 512;
constexpr int NPHASE = 3 + 8 * DEPTH;

constexpr size_t MiB = 1u << 20, KiB = 1u << 10;
constexpr size_t WS_CTL = 0, CTL_ZERO_BYTES = 1 * MiB;
constexpr size_t WS_MOD = 1 * MiB;
constexpr size_t WS_GM1 = 2 * MiB + 512 * KiB;
constexpr size_t WS_GM2 = 2 * MiB + 768 * KiB;
constexpr size_t WS_BIAS1 = 3 * MiB;
constexpr size_t WS_BIASR = 3 * MiB + 768 * KiB;
constexpr size_t WS_BIASGU = 4 * MiB;
constexpr size_t WS_SH = 6 * MiB;
constexpr size_t WS_KMEAN = 6 * MiB + 256 * KiB;
constexpr size_t WS_WTS = 6 * MiB + 512 * KiB;
constexpr size_t WS_RINV2 = 6 * MiB + 768 * KiB;
constexpr size_t WS_PART1 = 7 * MiB;
constexpr size_t WS_PART2 = 9 * MiB;
constexpr size_t WS_LIST = 11 * MiB;
constexpr size_t WS_WR = 14 * MiB;
constexpr size_t WS_WIN = 16 * MiB;
constexpr size_t WS_WOUT = 40 * MiB;
constexpr size_t WS_WGU = 48 * MiB;
constexpr size_t WS_WD = 112 * MiB;
constexpr size_t WS_XG = 144 * MiB;
constexpr size_t WS_UBCH = 208 * MiB;
constexpr size_t WS_HID = 208 * MiB;
constexpr size_t WS_Q = 304 * MiB, WS_K = 336 * MiB, WS_V = 368 * MiB;
constexpr size_t WS_YMIX = 400 * MiB;
constexpr size_t WS_YATT = 464 * MiB;
constexpr size_t WS_IGM1 = 496 * MiB;
constexpr size_t WS_IGM2 = 496 * MiB + 256 * KiB;
constexpr size_t WS_KMP = 497 * MiB;
constexpr size_t WS_PARTA = 498 * MiB;
constexpr size_t WS_END = 499 * MiB;
constexpr int CW_BAR = 4096;
constexpr int CW_CNT = 16384;

constexpr int RING_BYTES = 131072;
constexpr int MISC_OFF = RING_BYTES;
constexpr int LDS_BYTES = 147456;

__device__ __forceinline__ unsigned cvtpk(float lo, float hi) { f32x2 v = {lo, hi}; bf16x2_t b = __builtin_convertvector(v, bf16x2_t); return __builtin_bit_cast(unsigned, b); }
__device__ __forceinline__ float bflo(unsigned w) { return __uint_as_float(w << 16); }
__device__ __forceinline__ float bfhi(unsigned w) { return __uint_as_float(w & 0xffff0000u); }
__device__ __forceinline__ unsigned short f2bf(float f) { return (unsigned short)(cvtpk(f, 0.f) & 0xffffu); }
__device__ __forceinline__ float wave_sum(float v) {
#pragma unroll
    for (int o = 1; o < 64; o <<= 1) v += __shfl_xor(v, o);
    return v;
}
__device__ __forceinline__ float wave_max(float v) {
#pragma unroll
    for (int o = 1; o < 64; o <<= 1) v = fmaxf(v, __shfl_xor(v, o));
    return v;
}
__device__ __forceinline__ void unpack8(const u32x4 w, float (&x)[8]) {
    x[0] = bflo(w.x); x[1] = bfhi(w.x); x[2] = bflo(w.y); x[3] = bfhi(w.y); x[4] = bflo(w.z); x[5] = bfhi(w.z); x[6] = bflo(w.w); x[7] = bfhi(w.w);
}
__device__ __forceinline__ u32x4 pack8(const float (&x)[8]) { u32x4 w; w.x = cvtpk(x[0], x[1]); w.y = cvtpk(x[2], x[3]); w.z = cvtpk(x[4], x[5]); w.w = cvtpk(x[6], x[7]); return w; }
__device__ __forceinline__ int perm32(int rho) { const int n = rho >> 4, i = rho & 15; return 8 * (i >> 2) + 4 * n + (i & 3); }
__device__ __forceinline__ int opaque_tid() { int t = threadIdx.x; asm volatile("" : "+v"(t)); return t; }
__device__ __forceinline__ int opaque_bid() { int t = blockIdx.x; asm volatile("" : "+s"(t)); return t; }
__device__ __forceinline__ float silu_f(float x) { return x / (1.f + __expf(-x)); }

#define XB_TMO      128
#define XB_XCNT(j)  (256  + 64 * (j))
#define XB_XSUB(j)  (1280 + 64 * (j))
#define XB_XGEN(j)  (2304 + 64 * (j))
#define XB_TOP      3328
#define XB_TOPGEN   3392
#define XCD_BAR_WORDS 3456
#define XB_SPIN_CAP (1u << 18)
__device__ __forceinline__ unsigned xb_ld(unsigned* p)              { return __hip_atomic_load(p, __ATOMIC_RELAXED, __HIP_MEMORY_SCOPE_AGENT); }
__device__ __forceinline__ unsigned xb_add(unsigned* p, unsigned v) { return __hip_atomic_fetch_add(p, v, __ATOMIC_RELAXED, __HIP_MEMORY_SCOPE_AGENT); }
__device__ __forceinline__ unsigned xb_xcc_id() { return (unsigned)__builtin_amdgcn_s_getreg((3 << 11) | 20) & 0xFu; }
#define XB_SPIN(cond, bar) do { unsigned _sp = 0; while (cond) { __builtin_amdgcn_s_sleep(1); \
    if ((++_sp & 255u) == 0u) { if (xb_ld(&(bar)[XB_TMO])) break; if (_sp > XB_SPIN_CAP) { atomicAdd(&(bar)[XB_TMO], 1u); break; } } } } while (0)
struct XcdBarrier { unsigned* bar; unsigned x; volatile LAS unsigned* st; };
__device__ __forceinline__ XcdBarrier xcd_barrier_post(unsigned* bar, volatile LAS unsigned* st) {
    XcdBarrier b; b.bar = bar; b.x = xb_xcc_id(); b.st = st;
    if (threadIdx.x == 0) (void)xb_add(&bar[XB_XCNT(b.x)], 1u);
    return b;
}
__device__ __forceinline__ void xcd_barrier_complete(unsigned* bar, unsigned x, unsigned& nloc, unsigned& nx) {
    const unsigned G = gridDim.x * gridDim.y * gridDim.z;
    unsigned sum, cnt, mine, sp = 0u;
    for (;;) {
        sum = 0u; cnt = 0u; mine = 0u;
#pragma unroll
        for (unsigned j = 0; j < 16; ++j) { const unsigned c = xb_ld(&bar[XB_XCNT(j)]); sum += c; cnt += (c > 0u) ? 1u : 0u; mine = (j == x) ? c : mine; }
        if (sum == G) break;
        __builtin_amdgcn_s_sleep(1);
        if ((++sp & 255u) == 0u) { if (xb_ld(&bar[XB_TMO])) break; if (sp > XB_SPIN_CAP) { atomicAdd(&bar[XB_TMO], 1u); break; } }
    }
    nloc = mine > 0u ? mine : 1u; nx = cnt > 0u ? cnt : 1u;
}
__device__ __forceinline__ void xcd_barrier(const XcdBarrier& b) {
    asm volatile("s_waitcnt vmcnt(0)" ::: "memory");
    __syncthreads();
    if (threadIdx.x == 0) {
        unsigned* bar = b.bar; asm volatile("" : "+s"(bar));
        __builtin_amdgcn_s_waitcnt(0);
        unsigned nloc = b.st[0], nx = b.st[1];
        if (nloc == 0u) { xcd_barrier_complete(bar, b.x, nloc, nx); b.st[0] = nloc; b.st[1] = nx; }
        const unsigned old = xb_add(&bar[XB_XSUB(b.x)], 1u);
        const unsigned gen = old / nloc;
        if (old + 1u == (gen + 1u) * nloc) {
            __builtin_amdgcn_fence(__ATOMIC_RELEASE, "agent");
            asm volatile("s_waitcnt vmcnt(0)" ::: "memory");
            const unsigned og = xb_add(&bar[XB_TOP], 1u);
            const unsigned tg = og / nx;
            if (og + 1u == (tg + 1u) * nx) xb_add(&bar[XB_TOPGEN], 1u);
            else XB_SPIN(xb_ld(&bar[XB_TOPGEN]) == tg, bar);
            __builtin_amdgcn_fence(__ATOMIC_ACQUIRE, "agent");
            xb_add(&bar[XB_XGEN(b.x)], 1u);
            asm volatile("s_waitcnt vmcnt(0)" ::: "memory");
        } else {
            XB_SPIN(xb_ld(&bar[XB_XGEN(b.x)]) == gen, bar);
            __builtin_amdgcn_fence(__ATOMIC_ACQUIRE, "agent");
            asm volatile("s_waitcnt vmcnt(0)" ::: "memory");
        }
    }
    __syncthreads();
}

struct Args { const void* in[21]; float* out; unsigned char* ws; int ph_lo, ph_hi; };
struct Ctx {
    const Args* a; unsigned char* ws; float* out;
    int G, vcu, tid, lane, wave;
    __device__ __forceinline__ const float* inf(int i) const { return (const float*)a->in[i]; }
};
#define I_x (C.inf(0))
#define I_c (C.inf(1))
#define I_pos ((const int*)C.a->in[2])
#define I_norm1_g (C.inf(3))
#define I_norm2_g (C.inf(4))
#define I_w_ada (C.inf(5))
#define I_b_ada (C.inf(6))
#define I_w_in (C.inf(7))
#define I_conv_w (C.inf(8))
#define I_q_norm_g (C.inf(9))
#define I_k_norm_g (C.inf(10))
#define I_conv_out_g (C.inf(11))
#define I_attn_out_g (C.inf(12))
#define I_w_out (C.inf(13))
#define I_w_rg (C.inf(14))
#define I_b_rg (C.inf(15))
#define I_w_re (C.inf(16))
#define I_b_re (C.inf(17))
#define I_w_gate (C.inf(18))
#define I_w_up (C.inf(19))
#define I_w_down (C.inf(20))
#define W_ctl ((unsigned*)(C.ws + WS_CTL))
#define W_MOD ((float*)(C.ws + WS_MOD))
#define W_GM1 ((float*)(C.ws + WS_GM1))
#define W_GM2 ((float*)(C.ws + WS_GM2))
#define W_IGM1 ((float*)(C.ws + WS_IGM1))
#define W_IGM2 ((float*)(C.ws + WS_IGM2))
#define W_BIAS1 ((float*)(C.ws + WS_BIAS1))
#define W_BIASR ((float*)(C.ws + WS_BIASR))
#define W_BIASGU ((float*)(C.ws + WS_BIASGU))
#define W_KMEAN ((float*)(C.ws + WS_KMP))
#define W_WTS ((float*)(C.ws + WS_WTS))
#define W_RINV2 ((float*)(C.ws + WS_RINV2))
#define W_PART1 ((float*)(C.ws + WS_PART1))
#define W_PART2 ((float*)(C.ws + WS_PART2))
#define W_LIST ((int*)(C.ws + WS_LIST))
#define W_SH ((bf16_t*)(C.ws + WS_SH))
#define W_WR ((bf16_t*)(C.ws + WS_WR))
#define W_WIN ((bf16_t*)(C.ws + WS_WIN))
#define W_WOUT ((bf16_t*)(C.ws + WS_WOUT))
#define W_WGU ((bf16_t*)(C.ws + WS_WGU))
#define W_WD ((bf16_t*)(C.ws + WS_WD))
#define W_XG ((bf16_t*)(C.ws + WS_XG))
#define W_UBCH ((bf16_t*)(C.ws + WS_UBCH))
#define W_HID ((bf16_t*)(C.ws + WS_HID))
#define W_Q ((bf16_t*)(C.ws + WS_Q))
#define W_K ((bf16_t*)(C.ws + WS_K))
#define W_V ((bf16_t*)(C.ws + WS_V))
#define W_YMIX ((bf16_t*)(C.ws + WS_YMIX))
#define W_YATT ((bf16_t*)(C.ws + WS_YATT))
#define W_PARTA ((float*)(C.ws + WS_PARTA))

__device__ __forceinline__ void launder_ctx(Ctx& C) { asm volatile("" : "+s"(C.ws), "+s"(C.out)); }

struct GUnit {
    const bf16_t* A; const bf16_t* B0; const bf16_t* B1;
    const int* list;
    int row0, rmask, rcnt;
    int lda, ldb, nk, ksplit;
    int pm, pn, x0, x1, x2;
};
__device__ __forceinline__ int unit_row(const GUnit& u, int i) {
    if (u.list) { const int j = i < u.rcnt ? i : u.rcnt - 1; return u.list[j]; }
    return u.row0 + (i & u.rmask);
}
__device__ __forceinline__ int xcd_chunk(int L, int n) { const int q = n / 8, r = n % 8, xcd = L % 8, off = L / 8; return (xcd < r ? xcd * (q + 1) : r * (q + 1) + (xcd - r) * q) + off; }
__device__ __forceinline__ void tile_order(int wgid, int nM, int nN, int& pm, int& pn) {
    const int nig = 8 * nN, gid = wgid / nig, fm = gid * 8, gsz = (nM - fm) < 8 ? (nM - fm) : 8;
    pm = fm + ((wgid % nig) % gsz); pn = (wgid % nig) / gsz;
}

struct SchedDense {
    const bf16_t* A; const bf16_t* Bt; int nM, nN, K, G, c;
    __device__ __forceinline__ bool next(int i, GUnit& u) const {
        const int n = nM * nN; const long L = (long)i * G + c; if (L >= n) return false;
        const int w = xcd_chunk((int)L, n); int pm, pn; tile_order(w, nM, nN, pm, pn);
        u.A = A; u.B0 = Bt + (size_t)pn * 256 * K; u.B1 = u.B0; u.list = nullptr; u.row0 = pm * 256; u.rmask = -1; u.rcnt = 256;
        u.lda = K; u.ldb = K; u.nk = K / 64; u.ksplit = u.nk; u.pm = pm; u.pn = pn; u.x0 = u.x1 = u.x2 = 0; return true;
    }
};
struct SchedBias {
    const Ctx& C; int G, c;
    __device__ __forceinline__ bool next(int i, GUnit& u) const {
        const long L = (long)i * G + c; if (L >= 45 * DEPTH) return false;
        const int l = (int)L / 45, j = (int)L % 45;
        u.list = nullptr; u.row0 = 0; u.rmask = 15; u.rcnt = 256; u.lda = D; u.ldb = D; u.nk = D / 64; u.ksplit = u.nk; u.pm = l; u.pn = j;
        if (j < 12) { u.A = W_SH + (size_t)(l * 2 + 0) * 16 * D; u.B0 = W_WIN + ((size_t)l * INW + j * 256) * D; u.x0 = 0; u.x1 = 0; u.x2 = 0; }
        else if (j < 44) { const int e = (j - 12) >> 1, ch = (j - 12) & 1; u.A = W_SH + (size_t)(l * 2 + 1) * 16 * D; u.B0 = W_WGU + ((size_t)((l * 16 + e) * 2 + ch) * 256) * D; u.x0 = 1; u.x1 = e; u.x2 = ch; }
        else { u.A = W_SH + (size_t)(l * 2 + 1) * 16 * D; u.B0 = W_WR + (size_t)l * 256 * D; u.x0 = 2; u.x1 = 0; u.x2 = 0; }
        u.B1 = u.B0; return true;
    }
};
__device__ __forceinline__ void pair_ab(int pair, int& a, int& b) { a = (pair >= 3) + (pair >= 5); b = (a == 0) ? pair + 1 : (a == 1 ? pair - 1 : 3); }
struct SchedMoe {
    const Ctx& C; int l, G, c; const LAS int* tb; const LAS int* cn; bool down;
    __device__ __forceinline__ bool next(int i, GUnit& u) const {
        const int Tn = tb[NCLS], n = Tn * 4; const long L = (long)i * G + c; if (L >= n) return false;
        const int w = xcd_chunk((int)L, n); const int rt = w >> 2, pn = w & 3;
        int cls = 0;
#pragma unroll 1
        for (int k = 1; k < NCLS; ++k) if (tb[k] <= rt) cls = k;
        const int tic = rt - tb[cls], cnt = cn[cls];
        const int g = cls / 6, pair = cls % 6; int a, b; pair_ab(pair, a, b);
        const int ea = 4 * g + a, eb = 4 * g + b;
        u.pm = rt; u.pn = pn; u.rcnt = cnt - tic * 256; if (u.rcnt > 256) u.rcnt = 256;
        const int* lst = W_LIST + (size_t)cls * NTOK + tic * 256;
        if (!down) {
            const int slot = pn >> 1, ch = pn & 1, e = slot ? eb : ea;
            u.A = W_XG; u.lda = D; u.list = lst; u.row0 = 0; u.rmask = -1;
            u.B0 = W_WGU + ((size_t)((l * 16 + e) * 2 + ch) * 256) * D; u.B1 = u.B0; u.ldb = D; u.nk = 16; u.ksplit = 16;
            u.x0 = e; u.x1 = ch; u.x2 = slot;
        } else {
            u.A = W_HID; u.lda = 512; u.list = nullptr; u.row0 = rt * 256; u.rmask = -1;
            u.B0 = W_WD + ((size_t)(l * 16 + ea) * D + pn * 256) * FF; u.B1 = W_WD + ((size_t)(l * 16 + eb) * D + pn * 256) * FF - 4 * 64; u.ldb = FF; u.nk = 8; u.ksplit = 4;
            u.x0 = cls; u.x1 = tic; u.x2 = 0;
        }
        return true;
    }
};

typedef f32x4 Acc[2][2][4][2];

struct EpiBias { static constexpr bool HOOK = false; __device__ __forceinline__ void mid_prep(const GUnit&, LAS unsigned char*, int) const {}
    const Ctx& C;
    __device__ __forceinline__ void run(Acc& acc, const GUnit& u, int wr, int wc, int fr, int fq, LAS unsigned char*, int) const {
        if (wr != 0) return;
        const int l = u.pm, b = fr;
#pragma unroll
        for (int bj = 0; bj < 2; ++bj)
#pragma unroll
            for (int n = 0; n < 2; ++n) {
                const f32x4 v = acc[0][bj][0][n]; const int cc = 32 * wc + 8 * fq + 4 * n;
                if (u.x0 == 0) { *(f32x4*)(W_BIAS1 + (size_t)(l * 16 + b) * INW + u.pn * 256 + 128 * bj + cc) = v; }
                else if (u.x0 == 1) { *(f32x4*)(W_BIASGU + ((size_t)(l * 16 + b) * 16 + u.x1) * 512 + 256 * bj + u.x2 * 128 + cc) = v; }
                else if (bj == 0 && wc == 0) {
                    f32x4 o = v; const int col = 8 * fq + 4 * n;
#pragma unroll
                    for (int i = 0; i < 4; ++i) { const int cidx = col + i; float add = 0.f; if (cidx < 4) add = I_b_rg[l * 4 + cidx]; else if (cidx & 4) add = I_b_re[l * 16 + 4 * (cidx >> 3) + (cidx & 3)]; o[i] += add; }
                    *(f32x4*)(W_BIASR + (size_t)(l * 16 + b) * 32 + col) = o;
                }
            }
    }
};

struct EpiG1 { static constexpr bool HOOK = false; __device__ __forceinline__ void mid_prep(const GUnit&, LAS unsigned char*, int) const {}
    const Ctx& C; int l;
    __device__ __forceinline__ void run(Acc& acc, const GUnit& u, int wr, int wc, int fr, int fq, LAS unsigned char*, int) const {
        const int pm = u.pm, pn = u.pn, b = pm >> 3;
        {
            const float* bias = W_BIAS1 + (size_t)(l * 16 + b) * INW + pn * 256 + 32 * wc + 8 * fq;
            f32x4 bv[2][2];
#pragma unroll
            for (int bj = 0; bj < 2; ++bj)
#pragma unroll
                for (int n = 0; n < 2; ++n) bv[bj][n] = *(const f32x4*)(bias + 128 * bj + 4 * n);
#pragma unroll
            for (int ai = 0; ai < 2; ++ai)
#pragma unroll
                for (int m = 0; m < 4; ++m) {
                    const int tok = pm * 256 + 128 * ai + 64 * wr + 16 * m + fr;
                    const f32x4 p0 = *(const f32x4*)(W_PART1 + (size_t)tok * 4);
                    const float r = 1.0f / sqrtf(((p0.x + p0.y) + (p0.z + p0.w)) * (1.f / D) + EPS);
#pragma unroll
                    for (int bj = 0; bj < 2; ++bj)
#pragma unroll
                        for (int n = 0; n < 2; ++n) acc[ai][bj][m][n] = acc[ai][bj][m][n] * r + bv[bj][n];
                }
        }
        if (pn < 6 || pn >= 10) {
            bf16_t* dst; int ldd, colt;
            if (pn < 6) { dst = W_UBCH; ldd = 1536; colt = pn * 256; } else { dst = W_V; ldd = 512; colt = (pn - 10) * 256; }
#pragma unroll
            for (int ai = 0; ai < 2; ++ai)
#pragma unroll
                for (int m = 0; m < 4; ++m) {
                    const int tok = pm * 256 + 128 * ai + 64 * wr + 16 * m + fr;
#pragma unroll
                    for (int bj = 0; bj < 2; ++bj) {
                        const f32x4 v0 = acc[ai][bj][m][0], v1 = acc[ai][bj][m][1];
                        u32x4 w; w.x = cvtpk(v0.x, v0.y); w.y = cvtpk(v0.z, v0.w); w.z = cvtpk(v1.x, v1.y); w.w = cvtpk(v1.z, v1.w);
                        *(u32x4*)(dst + (size_t)tok * ldd + colt + 128 * bj + 32 * wc + 8 * fq) = w;
                    }
                }
        } else {
            const bool isk = pn >= 8; const int h = (pn & 1) * 4 + wc;
            bf16_t* dst = (isk ? W_K : W_Q) + h * 64 + 8 * fq;
            const float* gn = (isk ? I_k_norm_g : I_q_norm_g) + l * HD + 8 * fq;
            f32x4 gnv[2][2];
#pragma unroll
            for (int bj = 0; bj < 2; ++bj)
#pragma unroll
                for (int n = 0; n < 2; ++n) gnv[bj][n] = *(const f32x4*)(gn + 32 * bj + 4 * n);
            float invf[8];
#pragma unroll
            for (int j = 0; j < 8; ++j) invf[j] = exp2f(-(float)(8 * fq + j) * (13.287712379549449f / 32.f)) * 0.15915494309189535f;
            const float osc = isk ? 1.f : C2;
            f32x4 ks[2][2];
#pragma unroll
            for (int bj = 0; bj < 2; ++bj)
#pragma unroll
                for (int n = 0; n < 2; ++n) ks[bj][n] = (f32x4){0.f, 0.f, 0.f, 0.f};
#pragma unroll
            for (int ai = 0; ai < 2; ++ai)
#pragma unroll
                for (int m = 0; m < 4; ++m) {
                    const int tok = pm * 256 + 128 * ai + 64 * wr + 16 * m + fr;
                    const float pf = (float)I_pos[tok];
                    float ss = 0.f;
#pragma unroll
                    for (int bj = 0; bj < 2; ++bj)
#pragma unroll
                        for (int n = 0; n < 2; ++n) { const f32x4 t = acc[ai][bj][m][n]; ss += (t.x * t.x + t.y * t.y) + (t.z * t.z + t.w * t.w); }
                    ss += __shfl_xor(ss, 16); ss += __shfl_xor(ss, 32);
                    const float rn = 1.0f / sqrtf(ss * (1.f / HD) + EPS);
                    f32x4 o[2][2];
#pragma unroll
                    for (int n = 0; n < 2; ++n)
#pragma unroll
                        for (int i = 0; i < 4; ++i) {
                            const float x1 = acc[ai][0][m][n][i] * rn * gnv[0][n][i], x2 = acc[ai][1][m][n][i] * rn * gnv[1][n][i];
                            float rev = pf * invf[4 * n + i]; rev = rev - floorf(rev);
                            const float sn = __builtin_amdgcn_sinf(rev), cs = __builtin_amdgcn_cosf(rev);
                            const float o1 = x1 * cs - x2 * sn, o2 = x2 * cs + x1 * sn;
                            ks[0][n][i] += o1; ks[1][n][i] += o2;
                            o[0][n][i] = o1 * osc; o[1][n][i] = o2 * osc;
                        }
#pragma unroll
                    for (int bj = 0; bj < 2; ++bj) {
                        u32x4 w; w.x = cvtpk(o[bj][0].x, o[bj][0].y); w.y = cvtpk(o[bj][0].z, o[bj][0].w); w.z = cvtpk(o[bj][1].x, o[bj][1].y); w.w = cvtpk(o[bj][1].z, o[bj][1].w);
                        *(u32x4*)(dst + (size_t)tok * 512 + 32 * bj) = w;
                    }
                    asm volatile("" : "+v"(ks[0][0]), "+v"(ks[0][1]), "+v"(ks[1][0]), "+v"(ks[1][1]) :: "memory");
                }
            if (isk) {
                float* kp = W_KMEAN + ((size_t)(((b * NH + h) * NBLK + (pm & 7)) * 2 + wr)) * HD + 8 * fq;
#pragma unroll
                for (int bj = 0; bj < 2; ++bj)
#pragma unroll
                    for (int n = 0; n < 2; ++n) {
                        f32x4 t = ks[bj][n];
#pragma unroll
                        for (int i = 0; i < 4; ++i) { float x = t[i]; x += __shfl_xor(x, 1); x += __shfl_xor(x, 2); x += __shfl_xor(x, 4); x += __shfl_xor(x, 8); t[i] = x; }
                        if (fr == 0) *(f32x4*)(kp + 32 * bj + 4 * n) = t;
                    }
            }
        }
    }
};

struct EpiG2 { static constexpr bool HOOK = true;
    __device__ __forceinline__ void mid_prep(const GUnit& u, LAS unsigned char* lds, int tid) const {
        if (tid < 256) { const int tok = u.pm * 256 + tid; const f32x4 a = *(const f32x4*)(W_PARTA + (size_t)tok * 8), b = *(const f32x4*)(W_PARTA + (size_t)tok * 8 + 4);
            ((LAS float*)(lds + MISC_OFF + 6144))[tid] = 1.0f / sqrtf((((a.x + a.y) + (a.z + a.w)) + ((b.x + b.y) + (b.z + b.w))) * (1.f / AW) + EPS); }
    }
    const Ctx& C; int l; bool dummy;
    __device__ __forceinline__ void run(Acc& acc, const GUnit& u, int wr, int wc, int fr, int fq, LAS unsigned char* lds, int tid) const {
        LAS float* red = (LAS float*)(lds + MISC_OFF + 2048);
        bf16_t* xgo = dummy ? W_UBCH : W_XG; float* po = dummy ? W_PART1 : W_PART2;
        const int pm = u.pm, pn = u.pn, b = pm >> 3, cb = pn * 256 + 32 * wc + 8 * fq;
        const float* gate = W_MOD + (size_t)(l * 16 + b) * 6144 + 2048 + cb;
        const float* gm = W_GM2 + (size_t)(l * 16 + b) * D + cb;
        const float* ig = W_IGM1 + (size_t)(l * 16 + b) * D + cb;
        float ssr[8];
#pragma unroll
        for (int j = 0; j < 8; ++j) ssr[j] = 0.f;
#pragma unroll
        for (int bj = 0; bj < 2; ++bj) {
            const f32x4 gv0 = *(const f32x4*)(gate + 128 * bj), gv1 = *(const f32x4*)(gate + 128 * bj + 4), mv0 = *(const f32x4*)(gm + 128 * bj), mv1 = *(const f32x4*)(gm + 128 * bj + 4),
                        iv0 = *(const f32x4*)(ig + 128 * bj), iv1 = *(const f32x4*)(ig + 128 * bj + 4);
#pragma unroll
            for (int ai = 0; ai < 2; ++ai)
#pragma unroll
                for (int m = 0; m < 4; ++m) {
                    const int tok = pm * 256 + 128 * ai + 64 * wr + 16 * m + fr;
                    const size_t off = (size_t)tok * D + cb + 128 * bj;
                    const u32x4 xo = *(const u32x4*)(W_XG + off);
                    const f32x4 x0 = (f32x4){bflo(xo.x), bfhi(xo.x), bflo(xo.y), bfhi(xo.y)} * iv0, x1 = (f32x4){bflo(xo.z), bfhi(xo.z), bflo(xo.w), bfhi(xo.w)} * iv1;
                    const f32x4 n0 = x0 + gv0 * acc[ai][bj][m][0], n1 = x1 + gv1 * acc[ai][bj][m][1];
                    ssr[ai * 4 + m] += (n0.x * n0.x + n0.y * n0.y) + (n0.z * n0.z + n0.w * n0.w) + (n1.x * n1.x + n1.y * n1.y) + (n1.z * n1.z + n1.w * n1.w);
                    const f32x4 g0 = n0 * mv0, g1 = n1 * mv1;
                    u32x4 w; w.x = cvtpk(g0.x, g0.y); w.y = cvtpk(g0.z, g0.w); w.z = cvtpk(g1.x, g1.y); w.w = cvtpk(g1.z, g1.w);
                    *(u32x4*)(xgo + off) = w;
                    if (m == 3) __builtin_amdgcn_sched_barrier(0);
                }
        }
#pragma unroll
        for (int ai = 0; ai < 2; ++ai)
#pragma unroll
            for (int m = 0; m < 4; ++m) { float ss = ssr[ai * 4 + m]; ss += __shfl_xor(ss, 16); ss += __shfl_xor(ss, 32);
                if (fq == 0) red[(128 * ai + 64 * wr + 16 * m + fr) * 4 + wc] = ss; }
        asm volatile("s_waitcnt lgkmcnt(0)" ::: "memory"); __builtin_amdgcn_s_barrier(); asm volatile("" ::: "memory");
        if (tid < 256) { const f32x4 t = *(const LAS f32x4*)(red + tid * 4); po[(size_t)(pm * 256 + tid) * 4 + pn] = (t.x + t.y) + (t.z + t.w); }
    }
};

struct EpiR { static constexpr bool HOOK = false; __device__ __forceinline__ void mid_prep(const GUnit&, LAS unsigned char*, int) const {}
    const Ctx& C; int l; bool dummy;
    __device__ __forceinline__ void run(Acc& acc, const GUnit& u, int wr, int wc, int fr, int fq, LAS unsigned char* lds, int tid) const {
        LAS int* hist = (LAS int*)(lds + MISC_OFF + 1024); LAS int* base = hist + 32;
        if (tid < NCLS) hist[tid] = 0;
        __syncthreads();
        const int pm = u.pm, b = pm >> 3;
        int cls_r[8], lr_r[8];
        if (wc == 0) {
            const float* br = W_BIASR + (size_t)(l * 16 + b) * 32;
            const f32x4 bg = *(const f32x4*)(br), be = *(const f32x4*)(br + 8 * fq + 4);
#pragma unroll
            for (int ai = 0; ai < 2; ++ai)
#pragma unroll
                for (int m = 0; m < 4; ++m) {
                    const int tok = pm * 256 + 128 * ai + 64 * wr + 16 * m + fr;
                    const f32x4 p0 = *(const f32x4*)(W_PART2 + (size_t)tok * 4);
                    const float r2 = 1.0f / sqrtf(((p0.x + p0.y) + (p0.z + p0.w)) * (1.f / D) + EPS);
                    f32x4 gl = acc[ai][0][m][0] * r2 + bg;
                    const f32x4 el = acc[ai][0][m][1] * r2 + be;
#pragma unroll
                    for (int i = 0; i < 4; ++i) gl[i] = __shfl(gl[i], fr);
                    int gs = 0; float mx = gl[0];
#pragma unroll
                    for (int i = 1; i < 4; ++i) if (gl[i] > mx) { mx = gl[i]; gs = i; }
                    float den = 0.f;
#pragma unroll
                    for (int i = 0; i < 4; ++i) den += __expf(gl[i] - mx);
                    const float pg = 1.f / den;
                    float es[4];
#pragma unroll
                    for (int i = 0; i < 4; ++i) es[i] = __shfl(el[i], fr + 16 * gs);
                    int i1 = 0; float v1 = es[0];
#pragma unroll
                    for (int i = 1; i < 4; ++i) if (es[i] > v1) { v1 = es[i]; i1 = i; }
                    int i2 = -1; float v2 = -INFINITY;
#pragma unroll
                    for (int i = 0; i < 4; ++i) if (i != i1 && (i2 < 0 || es[i] > v2)) { v2 = es[i]; i2 = i; }
                    const float w1 = 1.f / (1.f + __expf(v2 - v1)), w2 = 1.f - w1;
                    const int a = i1 < i2 ? i1 : i2, bq = i1 < i2 ? i2 : i1;
                    const float wa = (i1 < i2 ? w1 : w2) * pg, wb = (i1 < i2 ? w2 : w1) * pg;
                    const int pair = (a == 0) ? bq - 1 : (a == 1 ? bq + 1 : 5);
                    const int cls = gs * 6 + pair;
                    int lr = 0;
                    if (fq == 0) {
                        lr = __hip_atomic_fetch_add(&hist[cls], 1, __ATOMIC_RELAXED, __HIP_MEMORY_SCOPE_WORKGROUP);
                        *(f32x2*)(W_WTS + (size_t)tok * 2) = (f32x2){wa, wb};
                        W_RINV2[tok] = r2;
                    }
                    cls_r[ai * 4 + m] = cls; lr_r[ai * 4 + m] = lr;
                }
        }
        __syncthreads();
        if (tid < NCLS) base[tid] = (int)__hip_atomic_fetch_add(W_ctl + CW_CNT + (dummy ? l + 4 : l) * 2048 + tid * 64, (unsigned)hist[tid], __ATOMIC_RELAXED, __HIP_MEMORY_SCOPE_AGENT);
        __syncthreads();
        if (wc == 0 && fq == 0) {
#pragma unroll
            for (int ai = 0; ai < 2; ++ai)
#pragma unroll
                for (int m = 0; m < 4; ++m) {
                    const int tok = pm * 256 + 128 * ai + 64 * wr + 16 * m + fr; const int cls = cls_r[ai * 4 + m];
                    (dummy ? (int*)(C.ws + WS_UBCH) : W_LIST)[(size_t)cls * NTOK + base[cls] + lr_r[ai * 4 + m]] = tok;
                }
        }
        __syncthreads();
    }
};

struct EpiG3 { static constexpr bool HOOK = false; __device__ __forceinline__ void mid_prep(const GUnit&, LAS unsigned char*, int) const {}
    const Ctx& C; int l;
    __device__ __forceinline__ void run(Acc& acc, const GUnit& u, int wr, int wc, int fr, int fq, LAS unsigned char*, int) const {
        const int e = u.x0, ch = u.x1, slot = u.x2, rt = u.pm;
#pragma unroll
        for (int ai = 0; ai < 2; ++ai)
#pragma unroll
            for (int m = 0; m < 4; ++m) {
                const int rl = 128 * ai + 64 * wr + 16 * m + fr;
                const int tok = u.list[rl < u.rcnt ? rl : u.rcnt - 1];
                const int b = tok >> 11; const float r2 = W_RINV2[tok], wt = W_WTS[(size_t)tok * 2 + slot];
                const float* bg = W_BIASGU + ((size_t)(l * 16 + b) * 16 + e) * 512 + ch * 128 + 32 * wc + 8 * fq;
                float h[8];
#pragma unroll
                for (int n = 0; n < 2; ++n) {
                    const f32x4 g = acc[ai][0][m][n] * r2 + *(const f32x4*)(bg + 4 * n);
                    const f32x4 uu = acc[ai][1][m][n] * r2 + *(const f32x4*)(bg + 256 + 4 * n);
#pragma unroll
                    for (int i = 0; i < 4; ++i) h[4 * n + i] = silu_f(g[i]) * uu[i] * wt;
                }
                *(u32x4*)(W_HID + (size_t)(rt * 256 + rl) * 512 + slot * 256 + ch * 128 + 32 * wc + 8 * fq) = pack8(h);
            }
    }
};

struct EpiG4 { static constexpr bool HOOK = false; __device__ __forceinline__ void mid_prep(const GUnit&, LAS unsigned char*, int) const {}
    const Ctx& C; int l; bool dummy;
    __device__ __forceinline__ void run(Acc& acc, const GUnit& u, int wr, int wc, int fr, int fq, LAS unsigned char* lds, int tid) const {
        LAS float* red = (LAS float*)(lds + MISC_OFF + 2048);
        bf16_t* xgo = dummy ? W_Q : W_XG; float* po = dummy ? W_PART2 : W_PART1; float* oo = dummy ? (float*)(C.ws + WS_Q) : C.out;
        const int cls = u.x0, tic = u.x1, pn = u.pn, cb = pn * 256 + 32 * wc + 8 * fq;
        const int* lst = W_LIST + (size_t)cls * NTOK + tic * 256;
#pragma unroll
        for (int ai = 0; ai < 2; ++ai)
#pragma unroll
            for (int m = 0; m < 4; ++m) {
                const int rl = 128 * ai + 64 * wr + 16 * m + fr; const bool valid = rl < u.rcnt;
                const int tok = lst[valid ? rl : u.rcnt - 1]; const int b = tok >> 11;
                const float* gate = W_MOD + (size_t)(l * 16 + b) * 6144 + 5120 + cb;
                const float* ig = W_IGM2 + (size_t)(l * 16 + b) * D + cb;
                const float* gm = W_GM1 + (size_t)(((l + 1) & 3) * 16 + b) * D + cb;
                float ss = 0.f;
#pragma unroll
                for (int bj = 0; bj < 2; ++bj) {
                    const size_t off = (size_t)tok * D + cb + 128 * bj;
                    const u32x4 xo = *(const u32x4*)(W_XG + off);
                    const f32x4 x0 = (f32x4){bflo(xo.x), bfhi(xo.x), bflo(xo.y), bfhi(xo.y)} * *(const f32x4*)(ig + 128 * bj), x1 = (f32x4){bflo(xo.z), bfhi(xo.z), bflo(xo.w), bfhi(xo.w)} * *(const f32x4*)(ig + 128 * bj + 4);
                    const f32x4 n0 = x0 + *(const f32x4*)(gate + 128 * bj) * acc[ai][bj][m][0], n1 = x1 + *(const f32x4*)(gate + 128 * bj + 4) * acc[ai][bj][m][1];
                    ss += (n0.x * n0.x + n0.y * n0.y) + (n0.z * n0.z + n0.w * n0.w) + (n1.x * n1.x + n1.y * n1.y) + (n1.z * n1.z + n1.w * n1.w);
                    if (valid) {
                        if (l < DEPTH - 1) {
                            const f32x4 g0 = n0 * *(const f32x4*)(gm + 128 * bj), g1 = n1 * *(const f32x4*)(gm + 128 * bj + 4);
                            u32x4 w; w.x = cvtpk(g0.x, g0.y); w.y = cvtpk(g0.z, g0.w); w.z = cvtpk(g1.x, g1.y); w.w = cvtpk(g1.z, g1.w);
                            *(u32x4*)(xgo + off) = w;
                        } else { *(f32x4*)(oo + off) = n0; *(f32x4*)(oo + off + 4) = n1; }
                    }
                }
                ss += __shfl_xor(ss, 16); ss += __shfl_xor(ss, 32);
                if (fq == 0) red[rl * 4 + wc] = ss;
            }
        if (l < DEPTH - 1) {
            asm volatile("s_waitcnt lgkmcnt(0)" ::: "memory"); __builtin_amdgcn_s_barrier(); asm volatile("" ::: "memory");
            if (tid < u.rcnt) { const f32x4 t = *(const LAS f32x4*)(red + tid * 4); po[(size_t)lst[tid] * 4 + pn] = (t.x + t.y) + (t.z + t.w); }
        }
    }
};

template <class Epi, class Sched>
__device__ __forceinline__ void gemm_simple(LAS unsigned char* lds, const Sched& S, const Epi& E) {
    const int tid = opaque_tid(), wid = __builtin_amdgcn_readfirstlane(tid >> 6), lane = tid & 63, wr = wid >> 2, wc = wid & 3, fr = lane & 15, fq = lane >> 4;
    GUnit u;
    for (int it = 0; S.next(it, u); ++it) {
        unsigned ra[2][4], rb[2][2];
#pragma unroll
        for (int ai = 0; ai < 2; ++ai)
#pragma unroll
            for (int m = 0; m < 4; ++m) ra[ai][m] = (unsigned)unit_row(u, 128 * ai + 64 * wr + 16 * m + fr) * (unsigned)u.lda + 8u * fq;
#pragma unroll
        for (int bj = 0; bj < 2; ++bj)
#pragma unroll
            for (int n = 0; n < 2; ++n) rb[bj][n] = (unsigned)(128 * bj + 32 * wc + perm32(16 * n + fr)) * (unsigned)u.ldb + 8u * fq;
        Acc acc;
#pragma unroll
        for (int a = 0; a < 2; ++a)
#pragma unroll
            for (int b = 0; b < 2; ++b)
#pragma unroll
                for (int m = 0; m < 4; ++m)
#pragma unroll
                    for (int n = 0; n < 2; ++n) acc[a][b][m][n] = (f32x4){0.f, 0.f, 0.f, 0.f};
        const int nks = 2 * u.nk;
        if constexpr (Epi::HOOK) { __syncthreads(); E.mid_prep(u, lds, tid); __syncthreads(); }
#pragma unroll 1
        for (int ks = 0; ks < nks; ++ks) {
            if constexpr (Epi::HOOK) { if (ks == u.nk) { const LAS float* rsl = (const LAS float*)(lds + MISC_OFF + 6144) + 64 * wr + fr;
#pragma unroll
                for (int a = 0; a < 2; ++a)
#pragma unroll
                    for (int m = 0; m < 4; ++m) { const float r = rsl[128 * a + 16 * m];
#pragma unroll
                        for (int b = 0; b < 2; ++b)
#pragma unroll
                            for (int n = 0; n < 2; ++n) acc[a][b][m][n] = acc[a][b][m][n] * r; } } }
            const bf16_t* Bp = ((ks >> 1) < u.ksplit ? u.B0 : u.B1) + ks * 32;
            const bf16_t* Ap = u.A + ks * 32;
            bf16x8 av[2][4], bv[2][2];
#pragma unroll
            for (int ai = 0; ai < 2; ++ai)
#pragma unroll
                for (int m = 0; m < 4; ++m) av[ai][m] = *(const bf16x8*)(Ap + ra[ai][m]);
#pragma unroll
            for (int bj = 0; bj < 2; ++bj)
#pragma unroll
                for (int n = 0; n < 2; ++n) bv[bj][n] = *(const bf16x8*)(Bp + rb[bj][n]);
#pragma unroll
            for (int ai = 0; ai < 2; ++ai)
#pragma unroll
                for (int bj = 0; bj < 2; ++bj)
#pragma unroll
                    for (int m = 0; m < 4; ++m)
#pragma unroll
                        for (int n = 0; n < 2; ++n) acc[ai][bj][m][n] = __builtin_amdgcn_mfma_f32_16x16x32_bf16(bv[bj][n], av[ai][m], acc[ai][bj][m][n], 0, 0, 0);
        }
        E.run(acc, u, wr, wc, fr, fq, lds, tid);
    }
}

constexpr int HTB = 128 * 64 * 2;
__device__ __forceinline__ int lds_byte(int r, int c) { const int st = (r >> 4) * 2 + (c >> 5), rr = r & 15, cc = c & 31, ob = rr * 64 + cc * 2; return st * 1024 + (ob ^ (((ob >> 9) & 1) << 5)); }
__device__ __forceinline__ void stage_rc(int b, int& R, int& Cc) { const int st = b / 1024, sb = b % 1024, swz = sb ^ (((sb >> 9) & 1) << 5); R = (st >> 1) * 16 + swz / 64; Cc = (st & 1) * 32 + (swz % 64) / 2; }

template <class Epi, class Sched, bool AFTER_DRAIN, bool NARROW = false>
__device__ __forceinline__ void gemm_pipe(LAS unsigned char* lds, const Sched& S, const Epi& E) {
    const int tid = opaque_tid(), wid = __builtin_amdgcn_readfirstlane(tid >> 6), lane = tid & 63, wr = wid >> 2, wc = wid & 3, fr = lane & 15, fq = lane >> 4;
    constexpr bool ALIGN_EPI = !AFTER_DRAIN;
    const unsigned ldsw = (unsigned)wid * 1024u;
    const int aoff = lds_byte(wr * 64 + fr, fq * 8), boff = lds_byte(wc * 32 + fr, fq * 8);
    GUnit cur, nxt;
    if (!S.next(0, cur)) return;
    unsigned vaC[2][2], vaN[2][2], vbC[2], vbN[2];
#define GP_VOFF(U, va, vb) do { int t2_ = tid; asm volatile("" : "+v"(t2_));   \
        int R0, C0, R1, C1; stage_rc(t2_ * 16, R0, C0); stage_rc(t2_ * 16 + 8192, R1, C1); const int Rb0 = (R0 & ~31) + perm32(R0 & 31), Rb1 = (R1 & ~31) + perm32(R1 & 31); \
        va[0][0] = ((unsigned)unit_row(U, R0) * (unsigned)(U).lda + (unsigned)C0) * 2u; va[0][1] = ((unsigned)unit_row(U, R1) * (unsigned)(U).lda + (unsigned)C1) * 2u; \
        va[1][0] = ((unsigned)unit_row(U, 128 + R0) * (unsigned)(U).lda + (unsigned)C0) * 2u; va[1][1] = ((unsigned)unit_row(U, 128 + R1) * (unsigned)(U).lda + (unsigned)C1) * 2u; \
        vb[0] = ((unsigned)Rb0 * (unsigned)(U).ldb + (unsigned)C0) * 2u; vb[1] = ((unsigned)Rb1 * (unsigned)(U).ldb + (unsigned)C1) * 2u; } while (0)
    GP_VOFF(cur, vaC, vbC);
#define GP_SA(b, h) (((b) * 2 + (h)) * HTB)
#define GP_SB(b, h) ((4 + (b) * 2 + (h)) * HTB)
#define GP_GLDS(gp, off) __builtin_amdgcn_global_load_lds((const unsigned*)(gp), (LAS unsigned*)(lds + (off)), 16, 0, 0)
#define GP_STAGE(bufoff, gbase, v0, v1) do { GP_GLDS((const char*)(gbase) + (v0), (bufoff) + ldsw); GP_GLDS((const char*)(gbase) + (v1), (bufoff) + ldsw + 8192); } while (0)
#define GP_APTR(U, t) ((const char*)(U).A + (size_t)(t) * 128)
#define GP_BPTR(U, t, h) ((const char*)((t) < (U).ksplit ? (U).B0 : (U).B1) + (size_t)(t) * 128 + (size_t)(h) * 256 * (size_t)(U).ldb)
#define GP_LDA(dst, b, h) do { _Pragma("unroll") for (int m = 0; m < 4; ++m) _Pragma("unroll") for (int k = 0; k < 2; ++k) dst[m][k] = *(const LAS bf16x8*)(lds + GP_SA(b, h) + aoff + m * 2048 + k * 1024); } while (0)
#define GP_LDB(dst, b, h) do { _Pragma("unroll") for (int n = 0; n < 2; ++n) _Pragma("unroll") for (int k = 0; k < 2; ++k) dst[n][k] = *(const LAS bf16x8*)(lds + GP_SB(b, h) + boff + n * 2048 + k * 1024); } while (0)
#define GP_MMA(ai, bj, At, Bt) do { if (NARROW && ((bj) != 0 || wc != 0)) break; __builtin_amdgcn_s_setprio(1); _Pragma("unroll") for (int m = 0; m < 4; ++m) _Pragma("unroll") for (int n = 0; n < 2; ++n) _Pragma("unroll") for (int k = 0; k < 2; ++k) \
        acc[ai][bj][m][n] = __builtin_amdgcn_mfma_f32_16x16x32_bf16(Bt[n][k], At[m][k], acc[ai][bj][m][n], 0, 0, 0); __builtin_amdgcn_s_setprio(0); } while (0)
#define GP_WAIT_V(n) asm volatile("s_waitcnt vmcnt(" #n ")" ::: "memory")
#define GP_WAIT_L(n) asm volatile("s_waitcnt lgkmcnt(" #n ")" ::: "memory")
#define GP_BAR __builtin_amdgcn_s_barrier()
#define GP_SCHED __builtin_amdgcn_sched_barrier(0)
    Acc acc;
#pragma unroll
    for (int a = 0; a < 2; ++a)
#pragma unroll
        for (int b = 0; b < 2; ++b)
#pragma unroll
            for (int m = 0; m < 4; ++m)
#pragma unroll
                for (int n = 0; n < 2; ++n) acc[a][b][m][n] = (f32x4){0.f, 0.f, 0.f, 0.f};
    bf16x8 At[4][2], B0[2][2], B1[2][2];
    GP_STAGE(GP_SB(0, 0), GP_BPTR(cur, 0, 0), vbC[0], vbC[1]); GP_STAGE(GP_SB(0, 1), GP_BPTR(cur, 0, 1), vbC[0], vbC[1]);
    GP_STAGE(GP_SA(0, 0), GP_APTR(cur, 0), vaC[0][0], vaC[0][1]); GP_STAGE(GP_SA(0, 1), GP_APTR(cur, 0), vaC[1][0], vaC[1][1]);
    if (wr == 1) GP_BAR;
    GP_WAIT_V(2); GP_BAR;
    GP_STAGE(GP_SB(1, 0), GP_BPTR(cur, 1, 0), vbC[0], vbC[1]); GP_STAGE(GP_SA(1, 0), GP_APTR(cur, 1), vaC[0][0], vaC[0][1]); GP_STAGE(GP_SB(1, 1), GP_BPTR(cur, 1, 1), vbC[0], vbC[1]);
    GP_WAIT_V(6); GP_BAR;
    int ui = 0;
    for (;;) {
        const bool has_next = S.next(ui + 1, nxt);
        if (has_next) { GP_VOFF(nxt, vaN, vbN); }
        else { nxt = cur; vaN[0][0] = vaC[0][0]; vaN[0][1] = vaC[0][1]; vaN[1][0] = vaC[1][0]; vaN[1][1] = vaC[1][1]; vbN[0] = vbC[0]; vbN[1] = vbC[1]; }
        const int nt = cur.nk;
        if constexpr (Epi::HOOK) E.mid_prep(cur, lds, tid);
        auto kiter = [&](int t) __attribute__((always_inline)) {
            const bool last = (t == nt - 2);
            const char* a2 = last ? GP_APTR(nxt, 0) : GP_APTR(cur, t + 2); const char* a3 = last ? GP_APTR(nxt, 1) : GP_APTR(cur, t + 3);
            const char* b20 = last ? GP_BPTR(nxt, 0, 0) : GP_BPTR(cur, t + 2, 0); const char* b21 = last ? GP_BPTR(nxt, 0, 1) : GP_BPTR(cur, t + 2, 1);
            const char* b30 = last ? GP_BPTR(nxt, 1, 0) : GP_BPTR(cur, t + 3, 0); const char* b31 = last ? GP_BPTR(nxt, 1, 1) : GP_BPTR(cur, t + 3, 1);
            const unsigned xa00 = last ? vaN[0][0] : vaC[0][0], xa01 = last ? vaN[0][1] : vaC[0][1], xa10 = last ? vaN[1][0] : vaC[1][0], xa11 = last ? vaN[1][1] : vaC[1][1];
            const unsigned xb0 = last ? vbN[0] : vbC[0], xb1 = last ? vbN[1] : vbC[1];
            GP_LDB(B0, 0, 0); GP_LDB(B1, 0, 1); GP_SCHED; GP_LDA(At, 0, 0); GP_STAGE(GP_SA(1, 1), GP_APTR(cur, t + 1), vaC[1][0], vaC[1][1]);
            GP_WAIT_V(8); GP_WAIT_L(0); GP_BAR; GP_MMA(0, 0, At, B0); GP_MMA(0, 1, At, B1); GP_BAR; GP_SCHED;
            GP_LDA(At, 0, 1); GP_STAGE(GP_SB(0, 0), b20, xb0, xb1); GP_STAGE(GP_SB(0, 1), b21, xb0, xb1); GP_STAGE(GP_SA(0, 0), a2, xa00, xa01);
            GP_WAIT_V(8); GP_WAIT_L(0); GP_BAR; GP_MMA(1, 0, At, B0); GP_MMA(1, 1, At, B1); GP_BAR; GP_SCHED;
            GP_LDB(B0, 1, 0); GP_LDB(B1, 1, 1); GP_SCHED; GP_LDA(At, 1, 0); GP_STAGE(GP_SA(0, 1), a2, xa10, xa11);
            GP_WAIT_V(8); GP_WAIT_L(0); GP_BAR; GP_MMA(0, 0, At, B0); GP_MMA(0, 1, At, B1); GP_BAR; GP_SCHED;
            GP_LDA(At, 1, 1); GP_STAGE(GP_SB(1, 0), b30, xb0, xb1); GP_STAGE(GP_SB(1, 1), b31, xb0, xb1); GP_STAGE(GP_SA(1, 0), a3, xa00, xa01);
            GP_WAIT_V(8); GP_WAIT_L(0); GP_BAR; GP_MMA(1, 0, At, B0); GP_MMA(1, 1, At, B1); GP_BAR; GP_SCHED;
        };
#pragma unroll 1
        for (int t = 0; t < nt; t += 2) {
            if constexpr (Epi::HOOK) { if (t == (nt >> 1)) { const LAS float* rsl = (const LAS float*)(lds + MISC_OFF + 6144) + 64 * wr + fr;
#pragma unroll
              for (int a = 0; a < 2; ++a)
#pragma unroll
                for (int m = 0; m < 4; ++m) { const float r = rsl[128 * a + 16 * m];
#pragma unroll
                    for (int b = 0; b < 2; ++b)
#pragma unroll
                        for (int n = 0; n < 2; ++n) acc[a][b][m][n] = acc[a][b][m][n] * r; } } }
            kiter(t);
        }
        if constexpr (ALIGN_EPI) { if (wr == 0) GP_BAR; }
        if constexpr (!AFTER_DRAIN) { int fr_e = fr, fq_e = fq, tid_e = tid; asm volatile("" : "+v"(fr_e), "+v"(fq_e), "+v"(tid_e));
            E.run(acc, cur, wr, wc, fr_e, fq_e, lds, tid_e); }
        if (!has_next) break;
#pragma unroll
        for (int a = 0; a < 2; ++a)
#pragma unroll
            for (int b = 0; b < 2; ++b)
#pragma unroll
                for (int m = 0; m < 4; ++m)
#pragma unroll
                    for (int n = 0; n < 2; ++n) acc[a][b][m][n] = (f32x4){0.f, 0.f, 0.f, 0.f};
        cur = nxt; vaC[0][0] = vaN[0][0]; vaC[0][1] = vaN[0][1]; vaC[1][0] = vaN[1][0]; vaC[1][1] = vaN[1][1]; vbC[0] = vbN[0]; vbC[1] = vbN[1]; ++ui;
        if constexpr (ALIGN_EPI) { if (wr == 1) GP_BAR; }
    }
    GP_WAIT_V(0);
    if constexpr (!ALIGN_EPI) { if (wr == 0) GP_BAR; }
    GP_BAR;
    if constexpr (AFTER_DRAIN) { E.run(acc, cur, wr, wc, fr, fq, lds, tid); }
#undef GP_VOFF
#undef GP_SA
#undef GP_SB
#undef GP_GLDS
#undef GP_STAGE
#undef GP_APTR
#undef GP_BPTR
#undef GP_LDA
#undef GP_LDB
#undef GP_MMA
#undef GP_WAIT_V
#undef GP_WAIT_L
#undef GP_BAR
#undef GP_SCHED
}

__device__ __forceinline__ void tr_item(const float* W, int N, int k0, int n0, bf16_t* dst  , int ldd, LAS float* scr, int lane, const float* ksc = nullptr  ) {
#pragma unroll 8
    for (int i = 0; i < 32; ++i) { const int kk = 2 * i + (lane >> 5); float w = W[(size_t)(k0 + kk) * N + n0 + (lane & 31)]; if (ksc) w *= ksc[kk]; scr[kk * 33 + (lane & 31)] = w; }
    asm volatile("s_waitcnt lgkmcnt(0)" ::: "memory");
    const int c = lane & 7;
#pragma unroll
    for (int j = 0; j < 4; ++j) { const int n = (lane >> 3) + 8 * j; const LAS float* s = scr + (8 * c) * 33 + n;
        u32x4 o; o.x = cvtpk(s[0 * 33], s[1 * 33]); o.y = cvtpk(s[2 * 33], s[3 * 33]); o.z = cvtpk(s[4 * 33], s[5 * 33]); o.w = cvtpk(s[6 * 33], s[7 * 33]);
        *(u32x4*)(dst + (size_t)n * ldd + 8 * c) = o; }
    asm volatile("s_waitcnt lgkmcnt(0)" ::: "memory");
}

__device__ __forceinline__ void phase_pa(const Ctx& C, LAS unsigned char* lds) {
    const int tid = opaque_tid(), lane = tid & 63, wave = __builtin_amdgcn_readfirstlane(tid >> 6);
    for (int item = blockIdx.x; item < 96; item += C.G) {
        const int l = item / 24, n0 = (item % 24) * 256;
        LAS float* cact = (LAS float*)lds;
        for (int i = tid; i < 16 * 1024; i += NTHR) { const int b = i >> 10, k = i & 1023; const float c = I_c[b * 1024 + k]; cact[k * 16 + b] = silu_f(c); }
        __syncthreads();
        f32x4 acc[16];
#pragma unroll
        for (int b = 0; b < 16; ++b) acc[b] = (f32x4){0.f, 0.f, 0.f, 0.f};
        const float* W = I_w_ada + ((size_t)l * 1024 + wave * 128) * 6144 + n0 + 4 * lane;
#pragma unroll 1
        for (int k = 0; k < 128; k += 4) {
            f32x4 w[4];
#pragma unroll
            for (int j = 0; j < 4; ++j) w[j] = *(const f32x4*)(W + (size_t)(k + j) * 6144);
#pragma unroll
            for (int j = 0; j < 4; ++j) {
                const LAS f32x4* cv = (const LAS f32x4*)(cact + (wave * 128 + k + j) * 16);
#pragma unroll
                for (int q = 0; q < 4; ++q) { const f32x4 cc = cv[q]; acc[4 * q + 0] += cc.x * w[j]; acc[4 * q + 1] += cc.y * w[j]; acc[4 * q + 2] += cc.z * w[j]; acc[4 * q + 3] += cc.w * w[j]; }
            }
        }
        __syncthreads();
        LAS float* red = (LAS float*)lds;
#pragma unroll
        for (int b = 0; b < 16; ++b) *(LAS f32x4*)(red + (wave * 16 + b) * 256 + 4 * lane) = acc[b];
        __syncthreads();
        for (int o = tid; o < 4096; o += NTHR) { const int b = o >> 8, ci = o & 255; float s = 0.f;
#pragma unroll
            for (int w = 0; w < 8; ++w) s += red[(w * 16 + b) * 256 + ci];
            W_MOD[(size_t)(l * 16 + b) * 6144 + n0 + ci] = s + I_b_ada[l * 6144 + n0 + ci]; }
        __syncthreads();
    }
    LAS float* scr = (LAS float*)(lds + wave * 16384);
    const int gw = blockIdx.x * NWAVES + wave, NGW = C.G * NWAVES;
    for (int it = gw; it < 8192 * DEPTH; it += NGW) {
        const int l = it >> 13; int r = it & 8191;
        if (r < 1536) { const int kb = r / 96, nb = r % 96, n0 = 32 * nb;
            const int drow = (n0 >= 1536 && n0 < 2560) ? (n0 & ~255) + 128 * ((n0 >> 5) & 1) + 32 * ((n0 >> 6) & 3) : n0;
            tr_item(I_w_in + (size_t)l * D * INW, INW, 64 * kb, n0, W_WIN + ((size_t)l * INW + drow) * D + 64 * kb, D, scr, lane); continue; }
        r -= 1536;
        if (r < 512) { const int kb = r / 32, nb = r % 32, k0 = 64 * kb;
            tr_item(I_w_out + (size_t)l * D * D, D, k0, 32 * nb, W_WOUT + ((size_t)l * D + 32 * nb) * D + ((k0 + 512) & 1023), D, scr, lane, k0 >= 512 ? I_attn_out_g + l * AW + (k0 - 512) : nullptr); continue; }
        r -= 512;
        if (r < 4096) { const int gu = r >> 11; r &= 2047; const int e = r >> 7, rr = r & 127, kb = rr / 8, nb = rr % 8, n0 = 32 * nb;
            const float* src = (gu ? I_w_up : I_w_gate) + (size_t)(l * 16 + e) * D * FF;
            bf16_t* dst = W_WGU + ((size_t)(((l * 16 + e) * 2 + (n0 >> 7)) * 2 + gu) * 128 + (n0 & 127)) * D + 64 * kb;
            tr_item(src, FF, 64 * kb, n0, dst, D, scr, lane); continue; }
        r -= 4096;
        { const int e = r >> 7, rr = r & 127, kb = rr / 32, nb = rr % 32;
          tr_item(I_w_down + (size_t)(l * 16 + e) * FF * D, D, 64 * kb, 32 * nb, W_WD + ((size_t)(l * 16 + e) * D + 32 * nb) * FF + 64 * kb, FF, scr, lane); }
    }
    const int gt = blockIdx.x * NTHR + tid, NGT = C.G * NTHR;
    for (int i = gt; i < DEPTH * 256 * 1024; i += NGT) {
        const int l = i >> 18, j = (i >> 10) & 255, k = i & 1023; float v = 0.f;
        if (j < 4) v = I_w_rg[((size_t)l * 1024 + k) * 4 + j]; else if (j < 32 && (j & 4)) v = I_w_re[((size_t)l * 1024 + k) * 16 + 4 * (j >> 3) + (j & 3)];
        W_WR[i] = f2bf(v);
    }
}

__device__ __forceinline__ void phase_pa2(const Ctx& C) {
    const int tid = opaque_tid(), lane = tid & 63, wave = __builtin_amdgcn_readfirstlane(tid >> 6);
    const int gt = blockIdx.x * NTHR + tid, NGT = C.G * NTHR;
    for (int i = gt; i < DEPTH * 16 * 1024; i += NGT) {
        const int l = i >> 14, b = (i >> 10) & 15, k = i & 1023; const float* m = W_MOD + (size_t)(l * 16 + b) * 6144;
        const float g1_ = I_norm1_g[l * 1024 + k] * (1.f + m[1024 + k]), g2_ = I_norm2_g[l * 1024 + k] * (1.f + m[4096 + k]);
        W_GM1[i] = g1_; W_GM2[i] = g2_; W_IGM1[i] = 1.f / g1_; W_IGM2[i] = 1.f / g2_;
        W_SH[(size_t)((l * 2 + 0) * 16 + b) * 1024 + k] = f2bf(m[k]); W_SH[(size_t)((l * 2 + 1) * 16 + b) * 1024 + k] = f2bf(m[3072 + k]);
    }
    const int gw = blockIdx.x * NWAVES + wave, NGW = C.G * NWAVES;
    for (int tok = gw; tok < NTOK; tok += NGW) {
        const int b = tok >> 11; const float* xr = I_x + (size_t)tok * D; const float* sc = W_MOD + (size_t)b * 6144 + 1024;
        float ss = 0.f;
#pragma unroll
        for (int j = 0; j < 4; ++j) {
            const int k = 4 * lane + 256 * j; const f32x4 v = *(const f32x4*)(xr + k), g = *(const f32x4*)(I_norm1_g + k), s = *(const f32x4*)(sc + k);
            ss += (v.x * v.x + v.y * v.y) + (v.z * v.z + v.w * v.w);
            const f32x4 o = v * g * (s + 1.f);
            u32x2 w; w.x = cvtpk(o.x, o.y); w.y = cvtpk(o.z, o.w); *(u32x2*)(W_XG + (size_t)tok * D + k) = w;
        }
        ss = wave_sum(ss);
        if (lane < 4) W_PART1[(size_t)tok * 4 + lane] = lane == 0 ? ss : 0.f;
    }
}

__device__ __forceinline__ void phase_t2(const Ctx& C, int l, int convreps) {
    const int tid = opaque_tid(), lane = tid & 63, gw = blockIdx.x * NWAVES + __builtin_amdgcn_readfirstlane(tid >> 6), NGW = C.G * NWAVES;
    for (int cr_ = 0; cr_ < convreps; ++cr_)
    for (int run = gw; run < NTOK / 16; run += NGW) {
        const int t0 = run * 16, ch0 = lane * 8;
        float cw0[8], cw1[8], cw2[8], og[8];
#pragma unroll
        for (int j = 0; j < 8; ++j) { cw0[j] = I_conv_w[(l * 3 + 0) * CW + ch0 + j]; cw1[j] = I_conv_w[(l * 3 + 1) * CW + ch0 + j]; cw2[j] = I_conv_w[(l * 3 + 2) * CW + ch0 + j]; og[j] = I_conv_out_g[l * CW + ch0 + j]; }
        float g1[8], g2[8];
#pragma unroll
        for (int j = 0; j < 8; ++j) { g1[j] = 0.f; g2[j] = 0.f; }
        if ((t0 & (SEQ - 1)) != 0) {
            float a[8], b[8];
            unpack8(*(const u32x4*)(W_UBCH + (size_t)(t0 - 2) * 1536 + 512 + ch0), a); unpack8(*(const u32x4*)(W_UBCH + (size_t)(t0 - 2) * 1536 + 1024 + ch0), b);
#pragma unroll
            for (int j = 0; j < 8; ++j) g2[j] = a[j] * b[j];
            unpack8(*(const u32x4*)(W_UBCH + (size_t)(t0 - 1) * 1536 + 512 + ch0), a); unpack8(*(const u32x4*)(W_UBCH + (size_t)(t0 - 1) * 1536 + 1024 + ch0), b);
#pragma unroll
            for (int j = 0; j < 8; ++j) g1[j] = a[j] * b[j];
        }
#pragma unroll 2
        for (int t = t0; t < t0 + 16; ++t) {
            float ub[8], uc[8], uh[8], y[8];
            const bf16_t* row = W_UBCH + (size_t)t * 1536 + ch0;
            unpack8(*(const u32x4*)(row), ub); unpack8(*(const u32x4*)(row + 512), uc); unpack8(*(const u32x4*)(row + 1024), uh);
            float ss = 0.f;
#pragma unroll
            for (int j = 0; j < 8; ++j) { const float g = uc[j] * uh[j]; y[j] = ub[j] * (cw0[j] * g2[j] + cw1[j] * g1[j] + cw2[j] * g); ss += y[j] * y[j]; g2[j] = g1[j]; g1[j] = g; }
            ss = wave_sum(ss);
            const float r = 1.0f / sqrtf(ss * (1.f / CW) + EPS);
#pragma unroll
            for (int j = 0; j < 8; ++j) y[j] = y[j] * r * og[j];
            *(u32x4*)(W_YMIX + (size_t)t * D + 512 + ch0) = pack8(y);
        }
    }
}

__device__ __forceinline__ void phase_attn_naive(const Ctx& C) {
    const int tid = opaque_tid(), lane = tid & 63, gw = blockIdx.x * NWAVES + __builtin_amdgcn_readfirstlane(tid >> 6), NGW = C.G * NWAVES;
    for (int item = gw; item < NB * NH * SEQ; item += NGW) {
        const int q = item & (SEQ - 1), h = (item >> 11) & 7, b = item >> 14, own = q >> 8, tok = b * SEQ + q;
        float qv[64];
        { const bf16_t* qp = W_Q + (size_t)tok * 512 + h * 64;
#pragma unroll
          for (int j = 0; j < 8; ++j) { float t[8]; unpack8(*(const u32x4*)(qp + 8 * j), t);
#pragma unroll
              for (int i = 0; i < 8; ++i) qv[8 * j + i] = t[i]; } }
        float gs; { const float* km = W_KMEAN + ((size_t)((b * NH + h) * NBLK + (lane & 7))) * 2 * HD; float s = 0.f;
#pragma unroll
            for (int d = 0; d < 64; ++d) s += qv[d] * (km[d] + km[64 + d]);
            gs = s; }
        float gsc[8];
#pragma unroll
        for (int j = 0; j < 8; ++j) gsc[j] = (j < own) ? __shfl(gs, j) : -INFINITY;
        unsigned sel = 0; const int nsel = own < 3 ? own : 3;
        for (int s = 0; s < nsel; ++s) { int bi = -1; float bv = -INFINITY;
#pragma unroll
            for (int j = 0; j < 8; ++j) if (j < own && !((sel >> j) & 1u) && (bi < 0 || gsc[j] > bv)) { bv = gsc[j]; bi = j; }
            sel |= 1u << bi; }
        float mrun = -INFINITY, lrun = 0.f, oacc = 0.f;
        for (int jb = 0; jb <= own; ++jb) {
            if (jb < own && !((sel >> jb) & 1u)) continue;
            for (int kk = 0; kk < 4; ++kk) {
                const int key = jb * 256 + kk * 64 + lane; const bf16_t* kp = W_K + (size_t)(b * SEQ + key) * 512 + h * 64;
                float s = 0.f;
#pragma unroll
                for (int j = 0; j < 8; ++j) { float t[8]; unpack8(*(const u32x4*)(kp + 8 * j), t);
#pragma unroll
                    for (int i = 0; i < 8; ++i) s += qv[8 * j + i] * t[i]; }
                if (jb == own && key > q) s = -INFINITY;
                const float cm = wave_max(s);
                if (cm == -INFINITY) continue;
                const float mn = fmaxf(mrun, cm), scl = exp2f(mrun - mn), p = exp2f(s - mn);
                lrun = lrun * scl + wave_sum(p); oacc *= scl; mrun = mn;
                const bf16_t* vp = W_V + (size_t)(b * SEQ + jb * 256 + kk * 64) * 512 + h * 64 + lane;
#pragma unroll 8
                for (int j = 0; j < 64; ++j) { const float pj = __shfl(p, j); oacc += pj * __uint_as_float((unsigned)vp[(size_t)j * 512] << 16); }
            }
        }
        W_YATT[(size_t)tok * 512 + h * 64 + lane] = f2bf(oacc / lrun);
    }
}

namespace attn_body {
typedef unsigned short bf16;
using bf16x8=__attribute__((ext_vector_type(8)))short;
using s16x4=__attribute__((ext_vector_type(4)))short;
using f32x16=__attribute__((ext_vector_type(16)))float;
using u32x4=__attribute__((ext_vector_type(4)))unsigned;
constexpr int BATCH=16,NHEAD=8,SEQ=2048,D=64,DM=NHEAD*D;
constexpr int NW=8,QBLK=32,QB=QBLK*NW,KVBLK=64,NQB=SEQ/QB;
constexpr int ATTN_PITCH=DM, ATTN_UNIT_ROWS=QB;
__device__ __forceinline__ int crow(int r,int hi){return (r&3)+8*(r>>2)+4*hi;}
#define SBAR() __builtin_amdgcn_sched_barrier(0)
__device__ __forceinline__ void cmask(f32x16&p0,f32x16&p1,int jb,int qrel,int hi){
  const float NEG=-INFINITY; int kb=64*jb+4*hi;
  #pragma unroll
  for(int r=0;r<16;++r){int kv=kb+(r&3)+8*(r>>2); if(kv>qrel)p0[r]=NEG; if(kv+32>qrel)p1[r]=NEG;}
}

constexpr int NSLOT=3, SLOTB=8192;
constexpr int LDS_K=0, LDS_V=NSLOT*SLOTB, LDS_WS=2*NSLOT*SLOTB, LDS_OST=LDS_WS+NW*64*4, LDS_BYTES=LDS_OST+NW*4096;
constexpr float C2=0.125f*1.4426950408889634f;
__device__ __forceinline__ void glds16(const void*gsrc,unsigned lds_dst){unsigned keep;
  asm volatile("s_mov_b32 %0, m0\n\ts_mov_b32 m0, %2\n\ts_nop 0\n\tglobal_load_lds_dwordx4 %1, off\n\ts_mov_b32 m0, %0":"=&s"(keep):"v"(gsrc),"s"(lds_dst):"memory");}
__device__ __forceinline__ float max3f(float a,float b,float c){float r;asm("v_max3_f32 %0, %1, %2, %3":"=v"(r):"v"(a),"v"(b),"v"(c));return r;}
__device__ __forceinline__ float max2f(float a,float b){float r;asm("v_max_f32_e32 %0, %1, %2":"=v"(r):"v"(a),"v"(b));return r;}
__device__ __forceinline__ float fadd_s(float a,float b){float r;asm("v_add_f32_e32 %0, %1, %2":"=v"(r):"v"(a),"v"(b));return r;}
__device__ __forceinline__ float fsub_s(float a,float b){float r;asm("v_sub_f32_e32 %0, %1, %2":"=v"(r):"v"(a),"v"(b));return r;}
typedef float f32x2_t __attribute__((ext_vector_type(2))); typedef __bf16 bf16x2_t __attribute__((ext_vector_type(2)));
__device__ __forceinline__ unsigned cvtpk_s(float lo,float hi){f32x2_t v={lo,hi};bf16x2_t b=__builtin_convertvector(v,bf16x2_t);return __builtin_bit_cast(unsigned,b);}
#define WAIT_BAR(N) asm volatile("s_waitcnt vmcnt(" #N ") lgkmcnt(0)\n\ts_barrier":::"memory")

__device__ __forceinline__ void qkt(f32x16&p0,f32x16&p1,const char*Kslot,const bf16x8*qr,const f32x16&negm,int r32,int hi){
  const char*kb=Kslot+hi*1024+r32*16;
  #pragma unroll
  for(int d0=0;d0<4;++d0){
    const bf16x8 b0=*reinterpret_cast<const bf16x8*>(kb+d0*2048);
    const bf16x8 b1=*reinterpret_cast<const bf16x8*>(kb+d0*2048+512);
    if(d0==0){p0=__builtin_amdgcn_mfma_f32_32x32x16_bf16(b0,qr[0],negm,0,0,0);p1=__builtin_amdgcn_mfma_f32_32x32x16_bf16(b1,qr[0],negm,0,0,0);}
    else{p0=__builtin_amdgcn_mfma_f32_32x32x16_bf16(b0,qr[d0],p0,0,0,0);p1=__builtin_amdgcn_mfma_f32_32x32x16_bf16(b1,qr[d0],p1,0,0,0);}}
}
typedef __attribute__((address_space(3))) const char* lds_cptr;
typedef short v4i16_t __attribute__((ext_vector_type(4)));
__device__ __forceinline__ void kload8(bf16x8*kf,lds_cptr kp){
  kf[0]=*(const __attribute__((address_space(3))) bf16x8*)(kp);      kf[1]=*(const __attribute__((address_space(3))) bf16x8*)(kp+512);
  kf[2]=*(const __attribute__((address_space(3))) bf16x8*)(kp+2048); kf[3]=*(const __attribute__((address_space(3))) bf16x8*)(kp+2560);
  kf[4]=*(const __attribute__((address_space(3))) bf16x8*)(kp+4096); kf[5]=*(const __attribute__((address_space(3))) bf16x8*)(kp+4608);
  kf[6]=*(const __attribute__((address_space(3))) bf16x8*)(kp+6144); kf[7]=*(const __attribute__((address_space(3))) bf16x8*)(kp+6656);
}
__device__ __forceinline__ void kload2(bf16x8*kf,lds_cptr kp,int j){ kf[2*j]=*(const __attribute__((address_space(3))) bf16x8*)(kp+j*2048); kf[2*j+1]=*(const __attribute__((address_space(3))) bf16x8*)(kp+j*2048+512); }
__device__ __forceinline__ s16x4 vtr(lds_cptr p){ return __builtin_bit_cast(s16x4,__builtin_amdgcn_ds_read_tr16_b64_v4i16((__attribute__((address_space(3))) v4i16_t*)p)); }
__device__ __forceinline__ float rowmax(const f32x16&p0,const f32x16&p1){
  float a=max3f(p0[0],p0[1],p1[0]),b=max3f(p0[2],p0[3],p1[1]);a=max3f(a,p1[2],p1[3]);
  #pragma unroll
  for(int r=4;r<16;r+=4){a=max3f(a,p0[r],p0[r+1]);b=max3f(b,p0[r+2],p0[r+3]);a=max3f(a,p1[r],p1[r+1]);b=max3f(b,p1[r+2],p1[r+3]);}
  const float m=max2f(a,b);
  auto rr=__builtin_amdgcn_permlane32_swap(__float_as_uint(m),__float_as_uint(m),false,false);
  return max2f(__uint_as_float(rr[0]),__uint_as_float(rr[1]));
}
__device__ __forceinline__ void pv(f32x16*o,int vb,bf16x8 pa0,bf16x8 pa1,bf16x8 pa2,bf16x8 pa3){
  #pragma unroll
  for(int d0=0;d0<2;++d0){s16x4 lo[4],hi[4];
    #pragma unroll
    for(int ks=0;ks<4;++ks){
      asm volatile("ds_read_b64_tr_b16 %0,%1 offset:%c2":"=&v"(lo[ks]):"v"(vb),"i"(d0*4096+ks*1024):"memory");
      asm volatile("ds_read_b64_tr_b16 %0,%1 offset:%c2":"=&v"(hi[ks]):"v"(vb),"i"(d0*4096+ks*1024+512):"memory");}
    asm volatile("s_waitcnt lgkmcnt(0)":::"memory");SBAR();
    #define PK(k) (bf16x8){lo[k][0],lo[k][1],lo[k][2],lo[k][3],hi[k][0],hi[k][1],hi[k][2],hi[k][3]}
    o[d0]=__builtin_amdgcn_mfma_f32_32x32x16_bf16(pa0,PK(0),o[d0],0,0,0);
    o[d0]=__builtin_amdgcn_mfma_f32_32x32x16_bf16(pa1,PK(1),o[d0],0,0,0);
    o[d0]=__builtin_amdgcn_mfma_f32_32x32x16_bf16(pa2,PK(2),o[d0],0,0,0);
    o[d0]=__builtin_amdgcn_mfma_f32_32x32x16_bf16(pa3,PK(3),o[d0],0,0,0);
    #undef PK
  }
}

#ifndef ATTN_STORE16
#define ATTN_STORE16(p,v) (*(u32x4*)(p)=(v))
#endif
template<int THRL> __device__ __forceinline__ void attn_unit(int b,int h,int qb,const bf16*Q,const bf16*__restrict__ K,const bf16*__restrict__ V,bf16*O,float*PA,const float*__restrict__ KM,char*shm){
  int tid_=threadIdx.x; asm volatile("":"+v"(tid_));
  const int tid=tid_,lane=tid&63,r32=lane&31,hi=lane>>5; const int wid=__builtin_amdgcn_readfirstlane(tid>>6);
  const long rowbase=(long)b*SEQ; const int q0=qb*QB;
  const bf16*Qw=Q+(rowbase+q0+wid*QBLK)*DM+h*D;
  const bf16*Kh=K+rowbase*DM+h*D,*Vh=V+rowbase*DM+h*D;
  const unsigned lds0=(unsigned)(uintptr_t)shm;
  float*wsf=(float*)(shm+LDS_WS)+wid*64;
  const bf16*ksrc=Kh+(long)lane*DM+wid*8;
  const bf16*vsrc=Vh+(long)(16*(wid&3)+(lane>>2))*DM+(wid>>2)*32+(lane&3)*8;
  const unsigned kdst=lds0+LDS_K+wid*1024, vdst=lds0+LDS_V+wid*1024;
  #define KT(t) (((t)<4)?(4*qb+(t)):((t)-4))
  #define DMA_K(t,slot) glds16(ksrc+(long)KT(t)*KVBLK*DM,(unsigned)__builtin_amdgcn_readfirstlane(kdst+(slot)))
  #define DMA_V(t,slot) glds16(vsrc+(long)KT(t)*KVBLK*DM,(unsigned)__builtin_amdgcn_readfirstlane(vdst+(slot)))
  const int vb0=(int)(lds0+LDS_V)+((lane>>4)&1)*32+(lane&3)*8+(4*hi+((lane&15)>>2))*64;
  const char*Kbase=shm+LDS_K; bf16x8 kf[8];
  const lds_cptr shm3=(lds_cptr)shm; const lds_cptr kp0=shm3+LDS_K+hi*1024+r32*16; const lds_cptr vp0=shm3+LDS_V+((lane>>4)&1)*32+(lane&3)*8+(4*hi+((lane&15)>>2))*64;
  const int NT=(q0+QB)/KVBLK;
  DMA_K(0,0);DMA_V(0,0);DMA_K(1,SLOTB);
  bf16x8 qr[4];
  #pragma unroll
  for(int d0=0;d0<4;++d0)qr[d0]=*reinterpret_cast<const bf16x8*>(&Qw[(long)r32*DM+d0*16+hi*8]);
  unsigned selm=0u;
  { float gs[7];
    #pragma unroll
    for(int j=0;j<7;++j){ float s=0.f;
      if(j<qb){ const float*km=KM+j*128+hi*8;
        #pragma unroll
        for(int d0=0;d0<4;++d0){ float4 k0=*reinterpret_cast<const float4*>(km+d0*16), k1=*reinterpret_cast<const float4*>(km+d0*16+4); { const float4 k2=*reinterpret_cast<const float4*>(km+64+d0*16), k3=*reinterpret_cast<const float4*>(km+64+d0*16+4); k0.x+=k2.x;k0.y+=k2.y;k0.z+=k2.z;k0.w+=k2.w;k1.x+=k3.x;k1.y+=k3.y;k1.z+=k3.z;k1.w+=k3.w; } const bf16x8 qq=qr[d0];
          s+=__uint_as_float(((unsigned)(unsigned short)qq[0])<<16)*k0.x+__uint_as_float(((unsigned)(unsigned short)qq[1])<<16)*k0.y+__uint_as_float(((unsigned)(unsigned short)qq[2])<<16)*k0.z+__uint_as_float(((unsigned)(unsigned short)qq[3])<<16)*k0.w
            +__uint_as_float(((unsigned)(unsigned short)qq[4])<<16)*k1.x+__uint_as_float(((unsigned)(unsigned short)qq[5])<<16)*k1.y+__uint_as_float(((unsigned)(unsigned short)qq[6])<<16)*k1.z+__uint_as_float(((unsigned)(unsigned short)qq[7])<<16)*k1.w; }
        s=s+__shfl_xor(s,32); }
      gs[j]=s; }
    if(qb<=3) selm=(1u<<qb)-1u;
    else{
      #pragma unroll
      for(int p=0;p<3;++p){ float best=-INFINITY; int bi=0;
        #pragma unroll
        for(int j=0;j<7;++j){ const bool ok=(j<qb)&&!((selm>>j)&1u)&&(gs[j]>best); best=ok?gs[j]:best; bi=ok?j:bi; }
        selm|=1u<<bi; } } }
  float mhat=0.f,l_reg=0.f,negm1=0.f;f32x16 o[2];o[0]=f32x16{};o[1]=f32x16{};
  const int qrel=wid*QBLK+r32;
  #define CMASK(P0,P1,t) do{const int t_=(t); if(t_<4){cmask(P0,P1,t_,qrel,hi);} }while(0)
  bool resc=false;
  #define START(P0,P1) do{ const float rm=rowmax(P0,P1); resc=false; \
    { const float dl=rm; mhat=fadd_s(mhat,dl); \
      _Pragma("unroll") for(int r=0;r<16;++r){P0[r]=fsub_s(P0[r],dl);P1[r]=fsub_s(P1[r],dl);} \
      negm1=-mhat; } \
    _Pragma("unroll") for(int r=0;r<16;++r)P0[r]=__builtin_amdgcn_exp2f(P0[r]); }while(0)
  #define RESC() do{ if(resc){ asm volatile("s_waitcnt lgkmcnt(0)":::"memory"); \
      _Pragma("unroll") for(int d_=0;d_<2;++d_) _Pragma("unroll") for(int r=0;r<16;++r)o[d_][r]*=wsf[crow(r,hi)]; } }while(0)
  f32x16 pA0,pA1,pB0,pB1;
  int sl_prev=0,sl_cur=0,sl_next=SLOTB;
  #define ROT() do{sl_prev=sl_cur;sl_cur=sl_next;sl_next=(sl_next==(NSLOT-1)*SLOTB)?0:sl_next+SLOTB;}while(0)
  DMA_K(2,2*SLOTB);
  WAIT_BAR(3);
  qkt(pA0,pA1,Kbase,qr,f32x16{},r32,hi);asm volatile("s_nop 15\n\ts_nop 7":"+v"(pA0),"+v"(pA1));CMASK(pA0,pA1,0);
  START(pA0,pA1);
  _Pragma("unroll") for(int r=0;r<16;++r)pA1[r]=__builtin_amdgcn_exp2f(pA1[r]);
  WAIT_BAR(0);
  DMA_K(3,0);DMA_V(1,SLOTB);
  ROT();
  kload8(kf,kp0+sl_cur);
  WAIT_BAR(2);
  s16x4 vlo[8],vhi[8]; u32x4 pw0,pw1,pw2,pw3;
  #define PKW(P,B) cvtpk_s(P[B],P[B+1])
  #define PAF(k) __builtin_bit_cast(bf16x8,pw##k)
  #define VFR(i) (bf16x8){vlo[i][0],vlo[i][1],vlo[i][2],vlo[i][3],vhi[i][0],vhi[i][1],vhi[i][2],vhi[i][3]}
  #define PIN(x) asm volatile("":"+v"(x))
  #define MX3(a,b,c) __builtin_fmaxf(__builtin_fmaxf((a),(b)),(c))
  #define GAPA(MF,A0,A1,A2,A3,W0,W1,PW) do{ MF; sacc+=A0; sacc+=A1; sacc+=A2; sacc+=A3; PIN(sacc); W0; W1; PIN(PW); SBAR(); }while(0)
  #define EX(v) __builtin_amdgcn_exp2f(v)
  #define GAPB(MF,X,B) do{ MF; X[B]=EX(X[B]); X[B+1]=EX(X[B+1]); X[B+2]=EX(X[B+2]); X[B+3]=EX(X[B+3]); PIN(X); SBAR(); }while(0)
  #define VRD(i) do{ vlo[i]=vtr(vp_+(((i)>>2)*4096+((i)&3)*1024)); vhi[i]=vtr(vp_+(((i)>>2)*4096+((i)&3)*1024+512)); }while(0)
  #define KRD(G,j) do{ if(G){ kload2(kf,kp0+sl_next,j); SBAR(); } }while(0)
  #define STEP(C0,C1,P0,P1,t,GK,GV,GL) do{ SBAR(); \
    const lds_cptr vp_=vp0+sl_prev; \
    const float cv_=(((t)<4)||((selm>>(((t)-4)>>2))&1u))?negm1:-INFINITY; _Pragma("unroll") for(int r=0;r<16;++r){C0[r]=cv_;C1[r]=cv_;} PIN(C0); PIN(C1); \
    VRD(0); SBAR(); float sacc=(P0[0]+P0[1]); \
    GAPA(C0=__builtin_amdgcn_mfma_f32_32x32x16_bf16(kf[0],qr[0],C0,0,0,0), P0[2],P0[3],P0[4],P0[5],     pw0[0]=PKW(P0,0), pw0[1]=PKW(P0,2), pw0); \
    VRD(4); SBAR(); GAPA(C1=__builtin_amdgcn_mfma_f32_32x32x16_bf16(kf[1],qr[0],C1,0,0,0), P0[6],P0[7],P0[8],P0[9],     pw0[2]=PKW(P0,4), pw0[3]=PKW(P0,6), pw0); \
    VRD(1); SBAR(); GAPA(C0=__builtin_amdgcn_mfma_f32_32x32x16_bf16(kf[2],qr[1],C0,0,0,0),   P0[10],P0[11],P0[12],P0[13], pw1[0]=PKW(P0,8), pw1[1]=PKW(P0,10), pw1); \
    VRD(5); SBAR(); GAPA(C1=__builtin_amdgcn_mfma_f32_32x32x16_bf16(kf[3],qr[1],C1,0,0,0),   P0[14],P0[15],P1[0],P1[1],   pw1[2]=PKW(P0,12),pw1[3]=PKW(P0,14), pw1); \
    VRD(2); SBAR(); GAPA(C0=__builtin_amdgcn_mfma_f32_32x32x16_bf16(kf[4],qr[2],C0,0,0,0),   P1[2],P1[3],P1[4],P1[5],     pw2[0]=PKW(P1,0), pw2[1]=PKW(P1,2), pw2); \
    VRD(6); SBAR(); GAPA(C1=__builtin_amdgcn_mfma_f32_32x32x16_bf16(kf[5],qr[2],C1,0,0,0),   P1[6],P1[7],P1[8],P1[9],     pw2[2]=PKW(P1,4), pw2[3]=PKW(P1,6), pw2); \
    VRD(3); SBAR(); GAPA(C0=__builtin_amdgcn_mfma_f32_32x32x16_bf16(kf[6],qr[3],C0,0,0,0),   P1[10],P1[11],P1[12],P1[13], pw3[0]=PKW(P1,8), pw3[1]=PKW(P1,10), pw3); \
    VRD(7); SBAR(); GAPA(C1=__builtin_amdgcn_mfma_f32_32x32x16_bf16(kf[7],qr[3],C1,0,0,0),   P1[14],P1[15],0.f,0.f,       pw3[2]=PKW(P1,12),pw3[3]=PKW(P1,14), pw3); \
    l_reg+=sacc; \
    if(GK){DMA_K((t)+3,sl_cur);} if(GV){DMA_V((t)+1,sl_next);} \
    CMASK(C0,C1,t); \
    { float a=MX3(C0[0],C0[1],C1[0]),b=MX3(C0[2],C0[3],C1[1]); a=MX3(a,C1[2],C1[3]); \
      _Pragma("unroll") for(int r=4;r<16;r+=4){a=MX3(a,C0[r],C0[r+1]);b=MX3(b,C0[r+2],C0[r+3]);a=MX3(a,C1[r],C1[r+1]);b=MX3(b,C1[r+2],C1[r+3]);} \
      float rm=__builtin_fmaxf(a,b); { auto rr=__builtin_amdgcn_permlane32_swap(__float_as_uint(rm),__float_as_uint(rm),false,false); rm=__builtin_fmaxf(__uint_as_float(rr[0]),__uint_as_float(rr[1])); } \
      resc=false; \
      if(__builtin_expect(__any(rm>(float)THRL),0)){ const float dl=__builtin_fmaxf(rm,0.f); mhat+=dl; \
        _Pragma("unroll") for(int r=0;r<16;++r){C0[r]-=dl;C1[r]-=dl;} \
        negm1=-mhat; \
        const float f=__builtin_amdgcn_exp2f(-dl); l_reg*=f; if(hi==0)wsf[r32]=f; resc=true; } } \
    SBAR(); \
    GAPB(o[0]=__builtin_amdgcn_mfma_f32_32x32x16_bf16(PAF(0),VFR(0),o[0],0,0,0), C0,0); \
    GAPB(o[1]=__builtin_amdgcn_mfma_f32_32x32x16_bf16(PAF(0),VFR(4),o[1],0,0,0), C0,4); \
    KRD(GL,0); GAPB(o[0]=__builtin_amdgcn_mfma_f32_32x32x16_bf16(PAF(1),VFR(1),o[0],0,0,0), C0,8); \
    KRD(GL,1); GAPB(o[1]=__builtin_amdgcn_mfma_f32_32x32x16_bf16(PAF(1),VFR(5),o[1],0,0,0), C0,12); \
    KRD(GL,2); GAPB(o[0]=__builtin_amdgcn_mfma_f32_32x32x16_bf16(PAF(2),VFR(2),o[0],0,0,0), C1,0); \
    KRD(GL,3); GAPB(o[1]=__builtin_amdgcn_mfma_f32_32x32x16_bf16(PAF(2),VFR(6),o[1],0,0,0), C1,4); \
    GAPB(o[0]=__builtin_amdgcn_mfma_f32_32x32x16_bf16(PAF(3),VFR(3),o[0],0,0,0), C1,8); \
    GAPB(o[1]=__builtin_amdgcn_mfma_f32_32x32x16_bf16(PAF(3),VFR(7),o[1],0,0,0), C1,12); \
    }while(0)
  int t=1;
  for(;t+5<NT;t+=2){
    STEP(pB0,pB1,pA0,pA1,t,true,true,true);     WAIT_BAR(2); RESC(); ROT();
    STEP(pA0,pA1,pB0,pB1,t+1,true,true,true);   WAIT_BAR(2); RESC(); ROT();
  }
  #define ENDW(tt) do{ if((tt)+3<NT){WAIT_BAR(2);} else if((tt)+2<NT){WAIT_BAR(1);} else {WAIT_BAR(0);} }while(0)
  for(;t+1<NT;t+=2){
    STEP(pB0,pB1,pA0,pA1,t,(t+3<NT),(t+1<NT),(t+1<NT));       ENDW(t);   RESC(); ROT();
    STEP(pA0,pA1,pB0,pB1,t+1,(t+4<NT),(t+2<NT),(t+2<NT));     ENDW(t+1); RESC(); ROT();
  }
  STEP(pB0,pB1,pA0,pA1,NT-1,false,false,false); RESC();
  { float sacc=pB0[0]+pB0[1]; _Pragma("unroll") for(int r=2;r<16;++r)sacc+=pB0[r]; _Pragma("unroll") for(int r=0;r<16;++r)sacc+=pB1[r]; l_reg+=sacc;
    pw0=(u32x4){PKW(pB0,0),PKW(pB0,2),PKW(pB0,4),PKW(pB0,6)};pw1=(u32x4){PKW(pB0,8),PKW(pB0,10),PKW(pB0,12),PKW(pB0,14)};pw2=(u32x4){PKW(pB1,0),PKW(pB1,2),PKW(pB1,4),PKW(pB1,6)};pw3=(u32x4){PKW(pB1,8),PKW(pB1,10),PKW(pB1,12),PKW(pB1,14)};
    SBAR(); pv(o,vb0+sl_cur,PAF(0),PAF(1),PAF(2),PAF(3)); }
  #undef PKW
  #undef PAF
  #undef VFR
  #undef PIN
  #undef MX3
  #undef GAPA
  #undef GAPB
  #undef EX
  #undef VRD
  #undef KRD
  #undef STEP
  #undef ENDW
  {auto rr=__builtin_amdgcn_permlane32_swap(__float_as_uint(l_reg),__float_as_uint(l_reg),false,false);l_reg=__uint_as_float(rr[0])+__uint_as_float(rr[1]);}
  if(hi==0)wsf[32+r32]=l_reg;asm volatile("s_waitcnt lgkmcnt(0)":::"memory");
  float rli[16];
  #pragma unroll
  for(int r=0;r<16;++r)rli[r]=__builtin_amdgcn_rcpf(wsf[32+crow(r,hi)]);
  constexpr int ODM=1024;
  bf16*Ow=O+(rowbase+q0+wid*QBLK)*ODM+h*D; float*PAw=PA+(rowbase+q0+wid*QBLK)*NHEAD+h;
  { bf16*stg=(bf16*)(shm+LDS_OST)+wid*2048;
    #pragma unroll
    for(int r=0;r<16;++r){const int orow=crow(r,hi);
      #pragma unroll
      for(int d0=0;d0<2;++d0)stg[orow*64+d0*32+r32]=(bf16)(cvtpk_s(o[d0][r]*rli[r],0.f)&0xffffu);}
    asm volatile("s_waitcnt lgkmcnt(0)":::"memory");
    #pragma unroll
    for(int i=0;i<4;++i){const int row=i*8+(lane>>3),ch=lane&7; const u32x4 v=*(const u32x4*)(stg+row*64+ch*8); ATTN_STORE16(Ow+(long)row*ODM+ch*8,v);
      float sq=0.f;
      #pragma unroll
      for(int e=0;e<4;++e){const float a0=__uint_as_float(v[e]<<16),a1=__uint_as_float(v[e]&0xffff0000u); sq+=a0*a0+a1*a1;}
      sq+=__shfl_xor(sq,1);sq+=__shfl_xor(sq,2);sq+=__shfl_xor(sq,4);
      if(ch==0)PAw[(long)row*NHEAD]=sq;} }
  asm volatile("s_waitcnt lgkmcnt(0)\n\ts_barrier":::"memory");
  #undef DMA_K
  #undef KT
  #undef DMA_V
  #undef CMASK
  #undef START
  #undef RESC
  #undef ROT
}
constexpr int ATTN_LDS_BYTES=LDS_BYTES;
template<int THRL=8> __device__ __forceinline__ void attn_phase(char*lds,const bf16*Q,const bf16*K,const bf16*V,bf16*O,float*PA,const float*KMEAN,int vcu,int G){
  for(int slot=vcu;slot<BATCH*NHEAD*2;slot+=G){ const int bh=slot>>1,s=slot&1;
    #pragma unroll 1
    for(int i=0;i<4;++i){ const int qb=(i==0)?(7-s):(i==1)?(5-s):(i==2)?(2+s):s;
      attn_unit<THRL>(bh/NHEAD,bh%NHEAD,qb,Q,K,V,O,PA,KMEAN+(long)bh*(SEQ/QB)*2*D,lds); } }
}
#undef SBAR
#undef WAIT_BAR
}

__device__ __forceinline__ void phase_t3(const Ctx& C, int l) {
    const int tid = opaque_tid(), lane = tid & 63, gw = blockIdx.x * NWAVES + __builtin_amdgcn_readfirstlane(tid >> 6), NGW = C.G * NWAVES;
    for (int tok = gw; tok < NTOK; tok += NGW) {
        float x[8]; unpack8(*(const u32x4*)(W_YATT + (size_t)tok * 512 + 8 * lane), x);
        float ss = 0.f;
#pragma unroll
        for (int j = 0; j < 8; ++j) ss += x[j] * x[j];
        ss = wave_sum(ss);
        const float r = 1.0f / sqrtf(ss * (1.f / AW) + EPS);
#pragma unroll
        for (int j = 0; j < 8; ++j) x[j] = x[j] * r * I_attn_out_g[l * AW + 8 * lane + j];
        *(u32x4*)(W_YMIX + (size_t)tok * D + 512 + 8 * lane) = pack8(x);
    }
}

__global__ void __launch_bounds__(NTHR, 2) fwd_kernel(Args args) {
    extern __shared__ __attribute__((aligned(16))) unsigned char lds_raw[];
    LAS unsigned char* lds = (LAS unsigned char*)lds_raw;
    Ctx C;
    C.a = &args; C.ws = args.ws; C.out = args.out;
    C.G = gridDim.x; C.tid = threadIdx.x; C.lane = C.tid & 63; C.wave = __builtin_amdgcn_readfirstlane(C.tid >> 6);
    { const int bx = blockIdx.x; C.vcu = (C.G % 8 == 0) ? (bx % 8) * (C.G / 8) + bx / 8 : bx; }

    volatile LAS unsigned* MISC = (volatile LAS unsigned*)(lds + MISC_OFF);
    for (int u = C.tid; u < (LDS_BYTES - MISC_OFF) / 4; u += NTHR) ((LAS unsigned*)(lds + MISC_OFF))[u] = 0u;
    __syncthreads();
    const int lo = args.ph_lo, hi = args.ph_hi;
    XcdBarrier bar; bar.bar = W_ctl + CW_BAR; bar.x = 0; bar.st = nullptr;
    if (hi - lo > 1) bar = xcd_barrier_post(W_ctl + CW_BAR, MISC + 8);
#ifndef PHM
#define PHM 0x7ff
#endif
#ifndef GPM
#define GPM 0x7ff
#endif
#ifndef DUPM
#define DUPM 0
#endif
#define REP(bit) for (int rep_ = 0; rep_ < (((DUPM) & (bit)) ? 2 : 1); ++rep_)
#define IN(k) (launder_ctx(C), lo <= (k) && (k) < hi)
#ifndef BARX
#define BARX 1
#endif
#define SEAM(k) do { if (IN(k) && IN((k) + 1)) { for (int bx_ = 0; bx_ < BARX; ++bx_) xcd_barrier(bar); } } while (0)

    if ((PHM & 1) && IN(0)) { REP(1) phase_pa(C, lds); } SEAM(0);
    if ((PHM & 2) && IN(1)) { REP(2) phase_pa2(C); } SEAM(1);
    if ((PHM & 4) && IN(2)) REP(4) { SchedBias S{C, C.G, opaque_bid()}; EpiBias E{C}; if (GPM & 4) gemm_pipe<EpiBias, SchedBias, false>(lds, S, E); else gemm_simple(lds, S, E); } SEAM(2);

#pragma unroll 1
    for (int l = 0; l < DEPTH; ++l) {
        const int pb = 3 + 8 * l;
        if ((PHM & 8) && IN(pb + 0)) REP(8) { SchedDense S{W_XG, W_WIN + (size_t)l * INW * D, NTOK / 256, INW / 256, D, C.G, opaque_bid()}; EpiG1 E{C, l}; if (GPM & 8) gemm_pipe<EpiG1, SchedDense, false>(lds, S, E); else gemm_simple(lds, S, E); } SEAM(pb + 0);
        if ((PHM & 16) && IN(pb + 1)) { phase_t2(C, l, (DUPM & 16) ? 2 : 1); }
        #ifndef ATTN_NAIVE
        if ((PHM & 32) && IN(pb + 2)) REP(32) { attn_body::attn_phase<8>((char*)lds_raw, W_Q, W_K, W_V, W_YMIX, W_PARTA, W_KMEAN, C.vcu, C.G); }
#else
        if ((PHM & 32) && IN(pb + 2)) { phase_attn_naive(C); }
#endif
        SEAM(pb + 2);
        if ((DUPM & 128) && IN(pb + 4)) { SchedDense S{W_YMIX, W_WOUT + (size_t)l * D * D, NTOK / 256, D / 256, D, C.G, opaque_bid()}; EpiG2 E{C, l, true}; gemm_pipe<EpiG2, SchedDense, false>(lds, S, E); }
        if ((PHM & 128) && IN(pb + 4)) { SchedDense S{W_YMIX, W_WOUT + (size_t)l * D * D, NTOK / 256, D / 256, D, C.G, opaque_bid()}; EpiG2 E{C, l, false}; if (GPM & 128) gemm_pipe<EpiG2, SchedDense, false>(lds, S, E); else gemm_simple(lds, S, E); } SEAM(pb + 4);
        if ((DUPM & 256) && IN(pb + 5)) { SchedDense S{W_XG, W_WR + (size_t)l * 256 * D, NTOK / 256, 1, D, C.G, opaque_bid()}; EpiR E{C, l, true}; gemm_pipe<EpiR, SchedDense, true, true>(lds, S, E); }
        if ((PHM & 256) && IN(pb + 5)) { SchedDense S{W_XG, W_WR + (size_t)l * 256 * D, NTOK / 256, 1, D, C.G, opaque_bid()}; EpiR E{C, l, false}; if ((GPM & 256) && C.G >= NTOK / 256) gemm_pipe<EpiR, SchedDense, true, true>(lds, S, E); else gemm_simple(lds, S, E); } SEAM(pb + 5);
        if (IN(pb + 6) || IN(pb + 7)) {
            LAS int* tb = (LAS int*)(lds + MISC_OFF + 256); LAS int* cn = tb + 32;
            __syncthreads();
            if (opaque_tid() == 0) { int acc = 0;
                for (int k = 0; k < NCLS; ++k) { const int cnt = (int)__hip_atomic_load(W_ctl + CW_CNT + l * 2048 + k * 64, __ATOMIC_RELAXED, __HIP_MEMORY_SCOPE_AGENT); tb[k] = acc; cn[k] = cnt; acc += (cnt + 255) >> 8; }
                tb[NCLS] = acc; }
            __syncthreads();
            if ((PHM & 512) && IN(pb + 6)) REP(512) { SchedMoe S{C, l, C.G, opaque_bid(), tb, cn, false}; EpiG3 E{C, l}; if (GPM & 512) gemm_pipe<EpiG3, SchedMoe, false>(lds, S, E); else gemm_simple(lds, S, E); } SEAM(pb + 6);
            if ((DUPM & 1024) && IN(pb + 7)) { SchedMoe S{C, l, C.G, opaque_bid(), tb, cn, true}; EpiG4 E{C, l, true}; gemm_pipe<EpiG4, SchedMoe, false>(lds, S, E); }
            if ((PHM & 1024) && IN(pb + 7)) { SchedMoe S{C, l, C.G, opaque_bid(), tb, cn, true}; EpiG4 E{C, l, false}; if (GPM & 1024) gemm_pipe<EpiG4, SchedMoe, false>(lds, S, E); else gemm_simple(lds, S, E); } SEAM(pb + 7);
        }
    }
#undef IN
#undef SEAM
}

extern "C" void kernel_launch(void* const* d_in, const int* in_sizes, int n_in, void* d_out, int out_size, void* d_ws, size_t ws_size, hipStream_t stream) {
    static int grid = 0;
    if (grid == 0) {
        if (n_in != 21 || out_size != NTOK * D || ws_size < WS_END) { fprintf(stderr, "kernel_launch: unexpected problem shape (n_in %d, out %d, ws %zu)\n", n_in, out_size, ws_size); grid = -1; return; }
        int dev = 0, cus = 0, per_cu = 0;
        if (hipGetDevice(&dev) != hipSuccess || hipDeviceGetAttribute(&cus, hipDeviceAttributeMultiprocessorCount, dev) != hipSuccess) { grid = -1; return; }
        if (hipFuncSetAttribute((const void*)fwd_kernel, hipFuncAttributeMaxDynamicSharedMemorySize, LDS_BYTES) != hipSuccess) { fprintf(stderr, "kernel_launch: hipFuncSetAttribute failed\n"); grid = -1; return; }
        if (hipOccupancyMaxActiveBlocksPerMultiprocessor(&per_cu, (const void*)fwd_kernel, NTHR, LDS_BYTES) != hipSuccess || per_cu < 1) { fprintf(stderr, "kernel_launch: occupancy query reports %d\n", per_cu); }
        (void)hipGetLastError();
        grid = cus;
    }
    if (grid < 0) return;
    (void)hipMemsetAsync((char*)d_ws + WS_CTL, 0, CTL_ZERO_BYTES, stream);
    Args a{};
    for (int i = 0; i < 21; ++i) a.in[i] = d_in[i];
    a.out = (float*)d_out; a.ws = (unsigned char*)d_ws;
#if MK_ONE_LAUNCH
    a.ph_lo = 0; a.ph_hi = NPHASE;
    hipLaunchKernelGGL(fwd_kernel, dim3(grid), dim3(NTHR), LDS_BYTES, stream, a);
#else
    for (int ph = 0; ph < NPHASE; ++ph) { a.ph_lo = ph; a.ph_hi = ph + 1; hipLaunchKernelGGL(fwd_kernel, dim3(grid), dim3(NTHR), LDS_BYTES, stream, a); }
#endif
}
```

```cpp
#include <hip/hip_runtime.h>
#include <cstdio>
#include <cstdint>

#define LAS __attribute__((address_space(3)))
#define GAS __attribute__((address_space(1)))
typedef unsigned short bf16_t;
typedef short bf16x8 __attribute__((ext_vector_type(8)));
typedef float f32x4 __attribute__((ext_vector_type(4)));
typedef float f32x2 __attribute__((ext_vector_type(2)));
typedef unsigned u32x4 __attribute__((ext_vector_type(4)));
typedef unsigned u32x2 __attribute__((ext_vector_type(2)));
typedef __bf16 bf16x2_t __attribute__((ext_vector_type(2)));

#ifndef MK_ONE_LAUNCH
#define MK_ONE_LAUNCH 1
#endif

constexpr int D = 1024, NB = 16, SEQ = 2048, DEPTH = 4, NTOK = NB * SEQ;
constexpr int CW = 512, AW = 512, NH = 8, HD = 64, INW = 3072, MBLK = 256, NBLK = SEQ / MBLK;
constexpr int NE = 16, FF = 256, NCLS = 24;
constexpr float EPS = 1e-6f;
constexpr float C2 = 0.125f * 1.4426950408889634f;
constexpr int NWAVES = 8, NTHR = 512;
constexpr int NPHASE = 3 + 8 * DEPTH;

constexpr size_t MiB = 1u << 20, KiB = 1u << 10;
constexpr size_t WS_CTL = 0, CTL_ZERO_BYTES = 1 * MiB;
constexpr size_t WS_MOD = 1 * MiB;
constexpr size_t WS_GM1 = 2 * MiB + 512 * KiB;
constexpr size_t WS_GM2 = 2 * MiB + 768 * KiB;
constexpr size_t WS_BIAS1 = 3 * MiB;
constexpr size_t WS_BIASR = 3 * MiB + 768 * KiB;
constexpr size_t WS_BIASGU = 4 * MiB;
constexpr size_t WS_SH = 6 * MiB;
constexpr size_t WS_KMEAN = 6 * MiB + 256 * KiB;
constexpr size_t WS_WTS = 6 * MiB + 512 * KiB;
constexpr size_t WS_RINV2 = 6 * MiB + 768 * KiB;
constexpr size_t WS_PART1 = 7 * MiB;
constexpr size_t WS_PART2 = 9 * MiB;
constexpr size_t WS_LIST = 11 * MiB;
constexpr size_t WS_WR = 14 * MiB;
constexpr size_t WS_WIN = 16 * MiB;
constexpr size_t WS_WOUT = 40 * MiB;
constexpr size_t WS_WGU = 48 * MiB;
constexpr size_t WS_WD = 112 * MiB;
constexpr size_t WS_XG = 144 * MiB;
constexpr size_t WS_UBCH = 208 * MiB;
constexpr size_t WS_HID = 208 * MiB;
constexpr size_t WS_Q = 304 * MiB, WS_K = 336 * MiB, WS_V = 368 * MiB;
constexpr size_t WS_YMIX = 400 * MiB;
constexpr size_t WS_YATT = 464 * MiB;
constexpr size_t WS_IGM1 = 496 * MiB;
constexpr size_t WS_IGM2 = 496 * MiB + 256 * KiB;
constexpr size_t WS_KMP = 497 * MiB;
constexpr size_t WS_PARTA = 498 * MiB;
constexpr size_t WS_GQ1 = 499 * MiB;
constexpr size_t WS_GQ2 = 499 * MiB + 128 * KiB;
constexpr size_t WS_GT2 = 499 * MiB + 256 * KiB;
constexpr size_t WS_END = 500 * MiB;
constexpr int CW_BAR = 4096;
constexpr int CW_CNT = 16384;

constexpr int RING_BYTES = 131072;
constexpr int MISC_OFF = RING_BYTES;
constexpr int LDS_BYTES = 147456;

__device__ __forceinline__ unsigned cvtpk(float lo, float hi) { f32x2 v = {lo, hi}; bf16x2_t b = __builtin_convertvector(v, bf16x2_t); return __builtin_bit_cast(unsigned, b); }
__device__ __forceinline__ float bflo(unsigned w) { return __uint_as_float(w << 16); }
__device__ __forceinline__ float bfhi(unsigned w) { return __uint_as_float(w & 0xffff0000u); }
__device__ __forceinline__ unsigned short f2bf(float f) { return (unsigned short)(cvtpk(f, 0.f) & 0xffffu); }
__device__ __forceinline__ float wave_sum(float v) {
#pragma unroll
    for (int o = 1; o < 64; o <<= 1) v += __shfl_xor(v, o);
    return v;
}
__device__ __forceinline__ float wave_max(float v) {
#pragma unroll
    for (int o = 1; o < 64; o <<= 1) v = fmaxf(v, __shfl_xor(v, o));
    return v;
}
__device__ __forceinline__ void unpack8(const u32x4 w, float (&x)[8]) {
    x[0] = bflo(w.x); x[1] = bfhi(w.x); x[2] = bflo(w.y); x[3] = bfhi(w.y); x[4] = bflo(w.z); x[5] = bfhi(w.z); x[6] = bflo(w.w); x[7] = bfhi(w.w);
}
__device__ __forceinline__ u32x4 pack8(const float (&x)[8]) { u32x4 w; w.x = cvtpk(x[0], x[1]); w.y = cvtpk(x[2], x[3]); w.z = cvtpk(x[4], x[5]); w.w = cvtpk(x[6], x[7]); return w; }
__device__ __forceinline__ int perm32(int rho) { const int n = rho >> 4, i = rho & 15; return 8 * (i >> 2) + 4 * n + (i & 3); }
__device__ __forceinline__ int opaque_tid() { int t = threadIdx.x; asm volatile("" : "+v"(t)); return t; }
__device__ __forceinline__ int opaque_bid() { int t = blockIdx.x; asm volatile("" : "+s"(t)); return t; }
__device__ __forceinline__ float silu_f(float x) { return x / (1.f + __expf(-x)); }

#define XB_TMO      128
#define XB_XCNT(j)  (256  + 64 * (j))
#define XB_XSUB(j)  (1280 + 64 * (j))
#define XB_XGEN(j)  (2304 + 64 * (j))
#define XB_TOP      3328
#define XB_TOPGEN   3392
#define XCD_BAR_WORDS 3456
#define XB_SPIN_CAP (1u << 18)
__device__ __forceinline__ unsigned xb_ld(unsigned* p)              { return __hip_atomic_load(p, __ATOMIC_RELAXED, __HIP_MEMORY_SCOPE_AGENT); }
__device__ __forceinline__ unsigned xb_add(unsigned* p, unsigned v) { return __hip_atomic_fetch_add(p, v, __ATOMIC_RELAXED, __HIP_MEMORY_SCOPE_AGENT); }
__device__ __forceinline__ unsigned xb_xcc_id() { return (unsigned)__builtin_amdgcn_s_getreg((3 << 11) | 20) & 0xFu; }
#define XB_SPIN(cond, bar) do { unsigned _sp = 0; while (cond) { __builtin_amdgcn_s_sleep(1); \
    if ((++_sp & 255u) == 0u) { if (xb_ld(&(bar)[XB_TMO])) break; if (_sp > XB_SPIN_CAP) { atomicAdd(&(bar)[XB_TMO], 1u); break; } } } } while (0)
struct XcdBarrier { unsigned* bar; unsigned x; volatile LAS unsigned* st; };
__device__ __forceinline__ XcdBarrier xcd_barrier_post(unsigned* bar, volatile LAS unsigned* st) {
    XcdBarrier b; b.bar = bar; b.x = xb_xcc_id(); b.st = st;
    if (threadIdx.x == 0) (void)xb_add(&bar[XB_XCNT(b.x)], 1u);
    return b;
}
__device__ __forceinline__ void xcd_barrier_complete(unsigned* bar, unsigned x, unsigned& nloc, unsigned& nx) {
    const unsigned G = gridDim.x * gridDim.y * gridDim.z;
    unsigned sum, cnt, mine, sp = 0u;
    for (;;) {
        sum = 0u; cnt = 0u; mine = 0u;
#pragma unroll
        for (unsigned j = 0; j < 16; ++j) { const unsigned c = xb_ld(&bar[XB_XCNT(j)]); sum += c; cnt += (c > 0u) ? 1u : 0u; mine = (j == x) ? c : mine; }
        if (sum == G) break;
        __builtin_amdgcn_s_sleep(1);
        if ((++sp & 255u) == 0u) { if (xb_ld(&bar[XB_TMO])) break; if (sp > XB_SPIN_CAP) { atomicAdd(&bar[XB_TMO], 1u); break; } }
    }
    nloc = mine > 0u ? mine : 1u; nx = cnt > 0u ? cnt : 1u;
}
__device__ __forceinline__ void xcd_barrier(const XcdBarrier& b) {
    asm volatile("s_waitcnt vmcnt(0)" ::: "memory");
    __syncthreads();
    if (threadIdx.x == 0) {
        unsigned* bar = b.bar; asm volatile("" : "+s"(bar));
        __builtin_amdgcn_s_waitcnt(0);
        unsigned nloc = b.st[0], nx = b.st[1];
        if (nloc == 0u) { xcd_barrier_complete(bar, b.x, nloc, nx); b.st[0] = nloc; b.st[1] = nx; }
        const unsigned old = xb_add(&bar[XB_XSUB(b.x)], 1u);
        const unsigned gen = old / nloc;
        if (old + 1u == (gen + 1u) * nloc) {
            __builtin_amdgcn_fence(__ATOMIC_RELEASE, "agent");
            asm volatile("s_waitcnt vmcnt(0)" ::: "memory");
            const unsigned og = xb_add(&bar[XB_TOP], 1u);
            const unsigned tg = og / nx;
            if (og + 1u == (tg + 1u) * nx) xb_add(&bar[XB_TOPGEN], 1u);
            else XB_SPIN(xb_ld(&bar[XB_TOPGEN]) == tg, bar);
            __builtin_amdgcn_fence(__ATOMIC_ACQUIRE, "agent");
            xb_add(&bar[XB_XGEN(b.x)], 1u);
            asm volatile("s_waitcnt vmcnt(0)" ::: "memory");
        } else {
            XB_SPIN(xb_ld(&bar[XB_XGEN(b.x)]) == gen, bar);
            __builtin_amdgcn_fence(__ATOMIC_ACQUIRE, "agent");
            asm volatile("s_waitcnt vmcnt(0)" ::: "memory");
        }
    }
    __syncthreads();
}

struct Args { const void* in[21]; float* out; unsigned char* ws; int ph_lo, ph_hi; };
struct Ctx {
    const Args* a; unsigned char* ws; float* out;
    int G, vcu, tid, lane, wave;
    __device__ __forceinline__ const float* inf(int i) const { return (const float*)a->in[i]; }
};
#define I_x (C.inf(0))
#define I_c (C.inf(1))
#define I_pos ((const int*)C.a->in[2])
#define I_norm1_g (C.inf(3))
#define I_norm2_g (C.inf(4))
#define I_w_ada (C.inf(5))
#define I_b_ada (C.inf(6))
#define I_w_in (C.inf(7))
#define I_conv_w (C.inf(8))
#define I_q_norm_g (C.inf(9))
#define I_k_norm_g (C.inf(10))
#define I_conv_out_g (C.inf(11))
#define I_attn_out_g (C.inf(12))
#define I_w_out (C.inf(13))
#define I_w_rg (C.inf(14))
#define I_b_rg (C.inf(15))
#define I_w_re (C.inf(16))
#define I_b_re (C.inf(17))
#define I_w_gate (C.inf(18))
#define I_w_up (C.inf(19))
#define I_w_down (C.inf(20))
#define W_ctl ((unsigned*)(C.ws + WS_CTL))
#define W_MOD ((float*)(C.ws + WS_MOD))
#define W_GM1 ((float*)(C.ws + WS_GM1))
#define W_GM2 ((float*)(C.ws + WS_GM2))
#define W_IGM1 ((float*)(C.ws + WS_IGM1))
#define W_IGM2 ((float*)(C.ws + WS_IGM2))
#define W_BIAS1 ((float*)(C.ws + WS_BIAS1))
#define W_BIASR ((float*)(C.ws + WS_BIASR))
#define W_BIASGU ((float*)(C.ws + WS_BIASGU))
#define W_KMEAN ((float*)(C.ws + WS_KMP))
#define W_WTS ((float*)(C.ws + WS_WTS))
#define W_RINV2 ((float*)(C.ws + WS_RINV2))
#define W_PART1 ((float*)(C.ws + WS_PART1))
#define W_PART2 ((float*)(C.ws + WS_PART2))
#define W_LIST ((int*)(C.ws + WS_LIST))
#define W_SH ((bf16_t*)(C.ws + WS_SH))
#define W_WR ((bf16_t*)(C.ws + WS_WR))
#define W_WIN ((bf16_t*)(C.ws + WS_WIN))
#define W_WOUT ((bf16_t*)(C.ws + WS_WOUT))
#define W_WGU ((bf16_t*)(C.ws + WS_WGU))
#define W_WD ((bf16_t*)(C.ws + WS_WD))
#define W_XG ((bf16_t*)(C.ws + WS_XG))
#define W_UBCH ((bf16_t*)(C.ws + WS_UBCH))
#define W_HID ((bf16_t*)(C.ws + WS_HID))
#define W_Q ((bf16_t*)(C.ws + WS_Q))
#define W_K ((bf16_t*)(C.ws + WS_K))
#define W_V ((bf16_t*)(C.ws + WS_V))
#define W_YMIX ((bf16_t*)(C.ws + WS_YMIX))
#define W_YATT ((bf16_t*)(C.ws + WS_YATT))
#define W_PARTA ((float*)(C.ws + WS_PARTA))
#define W_GQ1 ((bf16_t*)(C.ws + WS_GQ1))
#define W_GQ2 ((bf16_t*)(C.ws + WS_GQ2))
#define W_GT2 ((bf16_t*)(C.ws + WS_GT2))

__device__ __forceinline__ void launder_ctx(Ctx& C) { asm volatile("" : "+s"(C.ws), "+s"(C.out)); }

struct GUnit {
    const bf16_t* B0; const bf16_t* B1;
    const int* list;
    int row0, rcnt;
    int pm, pn, x0, x1, x2;
    int q;
};
__device__ __forceinline__ bool unit_on(int q, int ai, int wr) { return q < 0 || (q < 4 ? (ai == (q >> 1) && wr == (q & 1)) : ai == q - 4); }
template <class Sched> __device__ __forceinline__ int unit_row(const Sched& S, const GUnit& u, int i) {
    if (u.list) { const int j = i < u.rcnt ? i : u.rcnt - 1; return u.list[j]; }
    return u.row0 + (i & S.rmask());
}
__device__ __forceinline__ int xcd_chunk(int L, int n) { const int q = n / 8, r = n % 8, xcd = L % 8, off = L / 8; return (xcd < r ? xcd * (q + 1) : r * (q + 1) + (xcd - r) * q) + off; }
__device__ __forceinline__ void tile_order(int wgid, int nM, int nN, int& pm, int& pn) {
    const int nig = 8 * nN, gid = wgid / nig, fm = gid * 8, gsz = (nM - fm) < 8 ? (nM - fm) : 8;
    pm = fm + ((wgid % nig) % gsz); pn = (wgid % nig) / gsz;
}

struct SchedDense {
    const bf16_t* A; const bf16_t* Bt; int nM, nN, K, G, c;
    __device__ __forceinline__ int lda() const { return K; } __device__ __forceinline__ int ldb() const { return K; } __device__ __forceinline__ int nk() const { return K / 64; }
    __device__ __forceinline__ int ksplit() const { return K / 64; } __device__ __forceinline__ int rmask() const { return -1; }
    __device__ __forceinline__ bool next(int i, GUnit& u) const {
        const int n = nM * nN; const long L = (long)i * G + c; if (L >= n) return false;
        const int w = xcd_chunk((int)L, n); int pm, pn; tile_order(w, nM, nN, pm, pn);
        u.B0 = Bt + (size_t)pn * 256 * K; u.B1 = u.B0; u.list = nullptr; u.row0 = pm * 256; u.rcnt = 256;
        u.pm = pm; u.pn = pn; u.x0 = u.x1 = u.x2 = 0; u.q = -1; return true;
    }
};
struct SchedG1 {
    const bf16_t* A; const bf16_t* Bt; int G, c;
    __device__ __forceinline__ int lda() const { return D; } __device__ __forceinline__ int ldb() const { return D; } __device__ __forceinline__ int nk() const { return D / 64; }
    __device__ __forceinline__ int ksplit() const { return D / 64; } __device__ __forceinline__ int rmask() const { return -1; }
    __device__ __forceinline__ bool next(int i, GUnit& u) const {
        int pm, pn;
        if (G == 256) { if (i >= 6) return false; const int x = c & 7, j = c >> 3;
            if (i < 4) { pm = 16 * x + 4 * i + (j & 3); const int q = j >> 2; pn = q < 6 ? q : q + 4; }
            else { pm = 16 * x + 8 * (i - 4) + (j & 7); pn = 6 + (j >> 3); } }
        else { const int n = (NTOK / 256) * (INW / 256); const long L = (long)i * G + c; if (L >= n) return false; tile_order((int)L, NTOK / 256, INW / 256, pm, pn); }
        u.B0 = Bt + (size_t)pn * 256 * D; u.B1 = u.B0; u.list = nullptr; u.row0 = pm * 256; u.rcnt = 256;
        u.pm = pm; u.pn = pn; u.x0 = u.x1 = u.x2 = 0; u.q = -1; return true;
    }
};
struct SchedBias {
    const Ctx& C; const bf16_t* A; int G, c;
    __device__ __forceinline__ int lda() const { return D; } __device__ __forceinline__ int ldb() const { return D; } __device__ __forceinline__ int nk() const { return D / 64; }
    __device__ __forceinline__ int ksplit() const { return D / 64; } __device__ __forceinline__ int rmask() const { return 15; }
    __device__ __forceinline__ bool next(int i, GUnit& u) const {
        const long L = (long)i * G + c; if (L >= 45 * DEPTH) return false;
        const int l = (int)L / 45, j = (int)L % 45;
        u.list = nullptr; u.rcnt = 256; u.pm = l; u.pn = j; u.q = -1;
        if (j < 12) { u.row0 = (l * 2 + 0) * 16; u.B0 = W_WIN + ((size_t)l * INW + j * 256) * D; u.x0 = 0; u.x1 = 0; u.x2 = 0; }
        else if (j < 44) { const int e = (j - 12) >> 1, ch = (j - 12) & 1; u.row0 = (l * 2 + 1) * 16; u.B0 = W_WGU + ((size_t)((l * 16 + e) * 2 + ch) * 256) * D; u.x0 = 1; u.x1 = e; u.x2 = ch; }
        else { u.row0 = (l * 2 + 1) * 16; u.B0 = W_WR + (size_t)l * 256 * D; u.x0 = 2; u.x1 = 0; u.x2 = 0; }
        u.B1 = u.B0; return true;
    }
};
__device__ __forceinline__ void pair_ab(int pair, int& a, int& b) { a = (pair >= 3) + (pair >= 5); b = (a == 0) ? pair + 1 : (a == 1 ? pair - 1 : 3); }
struct SchedMoe {
    const Ctx& C; int l, G, c; const LAS int* tb; const LAS int* cn; bool down; const bf16_t* A;
    __device__ __forceinline__ int lda() const { return down ? 512 : D; } __device__ __forceinline__ int ldb() const { return down ? FF : D; } __device__ __forceinline__ int nk() const { return down ? 8 : 16; }
    __device__ __forceinline__ int ksplit() const { return down ? 4 : 16; } __device__ __forceinline__ int rmask() const { return -1; }
    __device__ __forceinline__ bool next(int i, GUnit& u) const {
        const int Tn = tb[NCLS], n = Tn * 4, rounds = n / G, nfull = rounds * G, tail = n - nfull;
        const int split = (tail > 0 && (G & 31) == 0 && tail * 4 <= G) ? 4 : ((tail > 0 && (G & 15) == 0 && tail * 2 <= G) ? 2 : 1);
        int w, q = -1;
        if (i < rounds) { w = xcd_chunk(i * G + c, nfull); }
        else if (i == rounds && tail > 0) {
            if (split == 1) { if (c >= tail) return false; w = nfull + c; }
            else { const int tu = ((c >> 3) / split) * 8 + (c & 7); if (tu >= tail) return false; w = nfull + tu; const int qq = (c >> 3) % split; q = split == 4 ? qq : 4 + qq; }
        } else return false;
        const int rt = w >> 2, pn = w & 3; u.q = q;
        int cls = 0;
#pragma unroll 1
        for (int k = 1; k < NCLS; ++k) if (tb[k] <= rt) cls = k;
        const int tic = rt - tb[cls], cnt = cn[cls];
        const int g = cls / 6, pair = cls % 6; int a, b; pair_ab(pair, a, b);
        const int ea = 4 * g + a, eb = 4 * g + b;
        u.pm = rt; u.pn = pn; u.rcnt = cnt - tic * 256; if (u.rcnt > 256) u.rcnt = 256;
        const int* lst = W_LIST + (size_t)cls * NTOK + tic * 256;
        if (!down) {
            const int slot = pn >> 1, ch = pn & 1, e = slot ? eb : ea;
            u.list = lst; u.row0 = 0;
            u.B0 = W_WGU + ((size_t)((l * 16 + e) * 2 + ch) * 256) * D; u.B1 = u.B0;
            u.x0 = e; u.x1 = ch; u.x2 = slot;
        } else {
            u.list = nullptr; u.row0 = rt * 256;
            u.B0 = W_WD + ((size_t)(l * 16 + ea) * D + pn * 256) * FF; u.B1 = W_WD + ((size_t)(l * 16 + eb) * D + pn * 256) * FF - 4 * 64;
            u.x0 = cls; u.x1 = tic; u.x2 = i & 1;
        }
        return true;
    }
};

typedef f32x4 Acc[2][2][4][2];

struct EpiBias { static constexpr bool HOOK = false; __device__ __forceinline__ void prep(const GUnit&, LAS unsigned char*, int) const {}
    const Ctx& C;
    __device__ __forceinline__ void run(Acc& acc, const GUnit& u, int wr, int wc, int fr, int fq, LAS unsigned char*, int) const {
        if (wr != 0) return;
        const int l = u.pm, b = fr;
#pragma unroll
        for (int bj = 0; bj < 2; ++bj)
#pragma unroll
            for (int n = 0; n < 2; ++n) {
                const f32x4 v = acc[0][bj][0][n]; const int cc = 32 * wc + 8 * fq + 4 * n;
                if (u.x0 == 0) { *(f32x4*)(W_BIAS1 + (size_t)(l * 16 + b) * INW + u.pn * 256 + 128 * bj + cc) = v; }
                else if (u.x0 == 1) { *(f32x4*)(W_BIASGU + ((size_t)(l * 16 + b) * 16 + u.x1) * 512 + 256 * bj + u.x2 * 128 + cc) = v; }
                else if (bj == 0 && wc == 0) {
                    f32x4 o = v; const int col = 8 * fq + 4 * n;
#pragma unroll
                    for (int i = 0; i < 4; ++i) { const int cidx = col + i; float add = 0.f; if (cidx < 4) add = I_b_rg[l * 4 + cidx]; else if (cidx & 4) add = I_b_re[l * 16 + 4 * (cidx >> 3) + (cidx & 3)]; o[i] += add; }
                    *(f32x4*)(W_BIASR + (size_t)(l * 16 + b) * 32 + col) = o;
                }
            }
    }
};

struct EpiG1 { static constexpr bool HOOK = false; __device__ __forceinline__ void prep(const GUnit&, LAS unsigned char*, int) const {}
    const Ctx& C; int l;
    __device__ __forceinline__ void run(Acc& acc, const GUnit& u, int wr, int wc, int fr, int fq, LAS unsigned char*, int) const {
        const int pm = u.pm, pn = u.pn, b = pm >> 3;
        {
            const float* bias = W_BIAS1 + (size_t)(l * 16 + b) * INW + pn * 256 + 32 * wc + 8 * fq;
            f32x4 bv[2][2];
#pragma unroll
            for (int bj = 0; bj < 2; ++bj)
#pragma unroll
                for (int n = 0; n < 2; ++n) bv[bj][n] = *(const f32x4*)(bias + 128 * bj + 4 * n);
#pragma unroll
            for (int ai = 0; ai < 2; ++ai)
#pragma unroll
                for (int m = 0; m < 4; ++m) {
                    const int tok = pm * 256 + 128 * ai + 64 * wr + 16 * m + fr;
                    const f32x4 p0 = *(const f32x4*)(W_PART1 + (size_t)tok * 4);
                    const float r = 1.0f / sqrtf(((p0.x + p0.y) + (p0.z + p0.w)) * (1.f / D) + EPS);
#pragma unroll
                    for (int bj = 0; bj < 2; ++bj)
#pragma unroll
                        for (int n = 0; n < 2; ++n) acc[ai][bj][m][n] = acc[ai][bj][m][n] * r + bv[bj][n];
                }
        }
        if (pn < 6 || pn >= 10) {
            bf16_t* dst; int ldd, colt;
            if (pn < 6) { dst = W_UBCH; ldd = 1536; colt = pn * 256; } else { dst = W_V; ldd = 512; colt = (pn - 10) * 256; }
#pragma unroll
            for (int ai = 0; ai < 2; ++ai)
#pragma unroll
                for (int m = 0; m < 4; ++m) {
                    const int tok = pm * 256 + 128 * ai + 64 * wr + 16 * m + fr;
#pragma unroll
                    for (int bj = 0; bj < 2; ++bj) {
                        const f32x4 v0 = acc[ai][bj][m][0], v1 = acc[ai][bj][m][1];
                        u32x4 w; w.x = cvtpk(v0.x, v0.y); w.y = cvtpk(v0.z, v0.w); w.z = cvtpk(v1.x, v1.y); w.w = cvtpk(v1.z, v1.w);
                        *(u32x4*)(dst + (size_t)tok * ldd + colt + 128 * bj + 32 * wc + 8 * fq) = w;
                    }
                }
        } else {
            const bool isk = pn >= 8; const int h = (pn & 1) * 4 + wc;
            bf16_t* dst = (isk ? W_K : W_Q) + h * 64 + 8 * fq;
            const float* gn = (isk ? I_k_norm_g : I_q_norm_g) + l * HD + 8 * fq;
            f32x4 gnv[2][2];
#pragma unroll
            for (int bj = 0; bj < 2; ++bj)
#pragma unroll
                for (int n = 0; n < 2; ++n) gnv[bj][n] = *(const f32x4*)(gn + 32 * bj + 4 * n);
            float invf[8];
#pragma unroll
            for (int j = 0; j < 8; ++j) invf[j] = exp2f(-(float)(8 * fq + j) * (13.287712379549449f / 32.f)) * 0.15915494309189535f;
            const float osc = isk ? 1.f : C2;
            f32x4 ks[2][2];
#pragma unroll
            for (int bj = 0; bj < 2; ++bj)
#pragma unroll
                for (int n = 0; n < 2; ++n) ks[bj][n] = (f32x4){0.f, 0.f, 0.f, 0.f};
#pragma unroll
            for (int ai = 0; ai < 2; ++ai)
#pragma unroll
                for (int m = 0; m < 4; ++m) {
                    const int tok = pm * 256 + 128 * ai + 64 * wr + 16 * m + fr;
                    const float pf = (float)I_pos[tok];
                    float ss = 0.f;
#pragma unroll
                    for (int bj = 0; bj < 2; ++bj)
#pragma unroll
                        for (int n = 0; n < 2; ++n) { const f32x4 t = acc[ai][bj][m][n]; ss += (t.x * t.x + t.y * t.y) + (t.z * t.z + t.w * t.w); }
                    ss += __shfl_xor(ss, 16); ss += __shfl_xor(ss, 32);
                    const float rn = 1.0f / sqrtf(ss * (1.f / HD) + EPS);
                    f32x4 o[2][2];
#pragma unroll
                    for (int n = 0; n < 2; ++n)
#pragma unroll
                        for (int i = 0; i < 4; ++i) {
                            const float x1 = acc[ai][0][m][n][i] * rn * gnv[0][n][i], x2 = acc[ai][1][m][n][i] * rn * gnv[1][n][i];
                            float rev = pf * invf[4 * n + i]; rev = rev - floorf(rev);
                            const float sn = __builtin_amdgcn_sinf(rev), cs = __builtin_amdgcn_cosf(rev);
                            const float o1 = x1 * cs - x2 * sn, o2 = x2 * cs + x1 * sn;
                            ks[0][n][i] += o1; ks[1][n][i] += o2;
                            o[0][n][i] = o1 * osc; o[1][n][i] = o2 * osc;
                        }
#pragma unroll
                    for (int bj = 0; bj < 2; ++bj) {
                        u32x4 w; w.x = cvtpk(o[bj][0].x, o[bj][0].y); w.y = cvtpk(o[bj][0].z, o[bj][0].w); w.z = cvtpk(o[bj][1].x, o[bj][1].y); w.w = cvtpk(o[bj][1].z, o[bj][1].w);
                        *(u32x4*)(dst + (size_t)tok * 512 + 32 * bj) = w;
                    }
                    asm volatile("" : "+v"(ks[0][0]), "+v"(ks[0][1]), "+v"(ks[1][0]), "+v"(ks[1][1]) :: "memory");
                }
            if (isk) {
                float* kp = W_KMEAN + ((size_t)(((b * NH + h) * NBLK + (pm & 7)) * 2 + wr)) * HD + 8 * fq;
#pragma unroll
                for (int bj = 0; bj < 2; ++bj)
#pragma unroll
                    for (int n = 0; n < 2; ++n) {
                        f32x4 t = ks[bj][n];
#pragma unroll
                        for (int i = 0; i < 4; ++i) { float x = t[i]; x += __shfl_xor(x, 1); x += __shfl_xor(x, 2); x += __shfl_xor(x, 4); x += __shfl_xor(x, 8); t[i] = x; }
                        if (fr == 0) *(f32x4*)(kp + 32 * bj + 4 * n) = t;
                    }
            }
        }
    }
};

struct EpiG2 { static constexpr bool HOOK = true;
    __device__ __forceinline__ void prep(const GUnit& u, LAS unsigned char* lds, int tid) const {
        asm volatile("" : "+v"(tid));
        if (tid < 256) { const int tok = u.pm * 256 + tid; const f32x4 a = *(const f32x4*)(W_PARTA + (size_t)tok * 8), b = *(const f32x4*)(W_PARTA + (size_t)tok * 8 + 4);
            ((LAS float*)(lds + MISC_OFF + 6144))[tid] = 1.0f / sqrtf((((a.x + a.y) + (a.z + a.w)) + ((b.x + b.y) + (b.z + b.w))) * (1.f / AW) + EPS); }
    }
    const Ctx& C; int l; bool dummy;
    __device__ __forceinline__ void run(Acc& acc, const GUnit& u, int wr, int wc, int fr, int fq, LAS unsigned char* lds, int tid) const {
        LAS float* red = (LAS float*)(lds + MISC_OFF + 2048);
        bf16_t* xgo = dummy ? W_UBCH : W_XG; float* po = dummy ? W_PART1 : W_PART2;
        const int pm = u.pm, pn = u.pn, b = pm >> 3, cb = pn * 256 + 32 * wc + 8 * fq;
        const float* gate = W_MOD + (size_t)(l * 16 + b) * 6144 + 2048 + cb;
        const float* gm = W_GM2 + (size_t)(l * 16 + b) * D + cb;
        const float* ig = W_IGM1 + (size_t)(l * 16 + b) * D + cb;
        float ssr[8];
#pragma unroll
        for (int j = 0; j < 8; ++j) ssr[j] = 0.f;
#pragma unroll
        for (int bj = 0; bj < 2; ++bj) {
            const f32x4 gv0 = *(const f32x4*)(gate + 128 * bj), gv1 = *(const f32x4*)(gate + 128 * bj + 4), mv0 = *(const f32x4*)(gm + 128 * bj), mv1 = *(const f32x4*)(gm + 128 * bj + 4),
                        iv0 = *(const f32x4*)(ig + 128 * bj), iv1 = *(const f32x4*)(ig + 128 * bj + 4);
#pragma unroll
            for (int ai = 0; ai < 2; ++ai)
#pragma unroll
                for (int m = 0; m < 4; ++m) {
                    const int tok = pm * 256 + 128 * ai + 64 * wr + 16 * m + fr;
                    const size_t off = (size_t)tok * D + cb + 128 * bj;
                    const u32x4 xo = *(const u32x4*)(W_XG + off);
                    const f32x4 x0 = (f32x4){bflo(xo.x), bfhi(xo.x), bflo(xo.y), bfhi(xo.y)} * iv0, x1 = (f32x4){bflo(xo.z), bfhi(xo.z), bflo(xo.w), bfhi(xo.w)} * iv1;
                    const f32x4 n0 = x0 + gv0 * acc[ai][bj][m][0], n1 = x1 + gv1 * acc[ai][bj][m][1];
                    ssr[ai * 4 + m] += (n0.x * n0.x + n0.y * n0.y) + (n0.z * n0.z + n0.w * n0.w) + (n1.x * n1.x + n1.y * n1.y) + (n1.z * n1.z + n1.w * n1.w);
                    const f32x4 g0 = n0 * mv0, g1 = n1 * mv1;
                    u32x4 w; w.x = cvtpk(g0.x, g0.y); w.y = cvtpk(g0.z, g0.w); w.z = cvtpk(g1.x, g1.y); w.w = cvtpk(g1.z, g1.w);
                    *(u32x4*)(xgo + off) = w;
                    if (m == 3) __builtin_amdgcn_sched_barrier(0);
                }
        }
#pragma unroll
        for (int ai = 0; ai < 2; ++ai)
#pragma unroll
            for (int m = 0; m < 4; ++m) { float ss = ssr[ai * 4 + m]; ss += __shfl_xor(ss, 16); ss += __shfl_xor(ss, 32);
                if (fq == 0) red[(128 * ai + 64 * wr + 16 * m + fr) * 4 + wc] = ss; }
        asm volatile("s_waitcnt lgkmcnt(0)" ::: "memory"); __builtin_amdgcn_s_barrier(); asm volatile("" ::: "memory");
        if (tid < 256) { const f32x4 t = *(const LAS f32x4*)(red + tid * 4); po[(size_t)(pm * 256 + tid) * 4 + pn] = (t.x + t.y) + (t.z + t.w); }
    }
};

struct EpiR { static constexpr bool HOOK = false; __device__ __forceinline__ void prep(const GUnit&, LAS unsigned char*, int) const {}
    const Ctx& C; int l; bool dummy;
    __device__ __forceinline__ void run(Acc& acc, const GUnit& u, int wr, int wc, int fr, int fq, LAS unsigned char* lds, int tid) const {
        LAS int* hist = (LAS int*)(lds + MISC_OFF + 1024); LAS int* base = hist + 32;
        if (tid < NCLS) hist[tid] = 0;
        __syncthreads();
        const int pm = u.pm, b = pm >> 3;
        int cls_r[8], lr_r[8];
        if (wc == 0) {
            const float* br = W_BIASR + (size_t)(l * 16 + b) * 32;
            const f32x4 bg = *(const f32x4*)(br), be = *(const f32x4*)(br + 8 * fq + 4);
#pragma unroll
            for (int ai = 0; ai < 2; ++ai)
#pragma unroll
                for (int m = 0; m < 4; ++m) {
                    const int tok = pm * 256 + 128 * ai + 64 * wr + 16 * m + fr;
                    const f32x4 p0 = *(const f32x4*)(W_PART2 + (size_t)tok * 4);
                    const float r2 = 1.0f / sqrtf(((p0.x + p0.y) + (p0.z + p0.w)) * (1.f / D) + EPS);
                    f32x4 gl = acc[ai][0][m][0] * r2 + bg;
                    const f32x4 el = acc[ai][0][m][1] * r2 + be;
#pragma unroll
                    for (int i = 0; i < 4; ++i) gl[i] = __shfl(gl[i], fr);
                    int gs = 0; float mx = gl[0];
#pragma unroll
                    for (int i = 1; i < 4; ++i) if (gl[i] > mx) { mx = gl[i]; gs = i; }
                    float den = 0.f;
#pragma unroll
                    for (int i = 0; i < 4; ++i) den += __expf(gl[i] - mx);
                    const float pg = 1.f / den;
                    float es[4];
#pragma unroll
                    for (int i = 0; i < 4; ++i) es[i] = __shfl(el[i], fr + 16 * gs);
                    int i1 = 0; float v1 = es[0];
#pragma unroll
                    for (int i = 1; i < 4; ++i) if (es[i] > v1) { v1 = es[i]; i1 = i; }
                    int i2 = -1; float v2 = -INFINITY;
#pragma unroll
                    for (int i = 0; i < 4; ++i) if (i != i1 && (i2 < 0 || es[i] > v2)) { v2 = es[i]; i2 = i; }
                    const float w1 = 1.f / (1.f + __expf(v2 - v1)), w2 = 1.f - w1;
                    const int a = i1 < i2 ? i1 : i2, bq = i1 < i2 ? i2 : i1;
                    const float wa = (i1 < i2 ? w1 : w2) * pg, wb = (i1 < i2 ? w2 : w1) * pg;
                    const int pair = (a == 0) ? bq - 1 : (a == 1 ? bq + 1 : 5);
                    const int cls = gs * 6 + pair;
                    int lr = 0;
                    if (fq == 0) {
                        lr = __hip_atomic_fetch_add(&hist[cls], 1, __ATOMIC_RELAXED, __HIP_MEMORY_SCOPE_WORKGROUP);
                        *(f32x2*)(W_WTS + (size_t)tok * 2) = (f32x2){wa, wb};
                        W_RINV2[tok] = r2;
                    }
                    cls_r[ai * 4 + m] = cls; lr_r[ai * 4 + m] = lr;
                }
        }
        __syncthreads();
        if (tid < NCLS) base[tid] = (int)__hip_atomic_fetch_add(W_ctl + CW_CNT + (dummy ? l + 4 : l) * 2048 + tid * 64, (unsigned)hist[tid], __ATOMIC_RELAXED, __HIP_MEMORY_SCOPE_AGENT);
        __syncthreads();
        if (wc == 0 && fq == 0) {
#pragma unroll
            for (int ai = 0; ai < 2; ++ai)
#pragma unroll
                for (int m = 0; m < 4; ++m) {
                    const int tok = pm * 256 + 128 * ai + 64 * wr + 16 * m + fr; const int cls = cls_r[ai * 4 + m];
                    (dummy ? (int*)(C.ws + WS_UBCH) : W_LIST)[(size_t)cls * NTOK + base[cls] + lr_r[ai * 4 + m]] = tok;
                }
        }
        __syncthreads();
    }
};

struct EpiG3 { static constexpr bool HOOK = false; __device__ __forceinline__ void prep(const GUnit&, LAS unsigned char*, int) const {}
    const Ctx& C; int l;
    __device__ __forceinline__ void run(Acc& acc, const GUnit& u, int wr, int wc, int fr, int fq, LAS unsigned char*, int) const {
        const int e = u.x0, ch = u.x1, slot = u.x2, rt = u.pm;
#pragma unroll
        for (int ai = 0; ai < 2; ++ai)
#pragma unroll
            for (int m = 0; m < 4; ++m) {
                if (!unit_on(u.q, ai, wr)) continue;
                const int rl = 128 * ai + 64 * wr + 16 * m + fr;
                const int tok = u.list[rl < u.rcnt ? rl : u.rcnt - 1];
                const int b = tok >> 11; const float r2 = W_RINV2[tok], wt = W_WTS[(size_t)tok * 2 + slot];
                const float* bg = W_BIASGU + ((size_t)(l * 16 + b) * 16 + e) * 512 + ch * 128 + 32 * wc + 8 * fq;
                float h[8];
#pragma unroll
                for (int n = 0; n < 2; ++n) {
                    const f32x4 g = acc[ai][0][m][n] * r2 + *(const f32x4*)(bg + 4 * n);
                    const f32x4 uu = acc[ai][1][m][n] * r2 + *(const f32x4*)(bg + 256 + 4 * n);
#pragma unroll
                    for (int i = 0; i < 4; ++i) h[4 * n + i] = silu_f(g[i]) * uu[i] * wt;
                }
                *(u32x4*)(W_HID + (size_t)(rt * 256 + rl) * 512 + slot * 256 + ch * 128 + 32 * wc + 8 * fq) = pack8(h);
            }
    }
};

struct EpiG4 { static constexpr bool HOOK = false;
    const Ctx& C; int l; bool dummy;
    __device__ __forceinline__ void prep(const GUnit& u, LAS unsigned char* lds, int tid) const {
        asm volatile("" : "+v"(tid));
        if (tid < 256) { const int* lst = W_LIST + (size_t)u.x0 * NTOK + u.x1 * 256; ((LAS int*)(lds + MISC_OFF + 7168))[u.x2 * 256 + tid] = lst[tid < u.rcnt ? tid : u.rcnt - 1]; }
    }
    __device__ __forceinline__ void run(Acc& acc, const GUnit& u, int wr, int wc, int fr, int fq, LAS unsigned char* lds, int tid) const {
        LAS float* red = (LAS float*)(lds + MISC_OFF + 2048);
        const LAS int* tokl = (const LAS int*)(lds + MISC_OFF + 7168) + u.x2 * 256;
        bf16_t* xgo = dummy ? W_Q : W_XG; float* po = dummy ? W_PART2 : W_PART1; float* oo = dummy ? (float*)(C.ws + WS_Q) : C.out;
        const int pn = u.pn, cb = pn * 256 + 32 * wc + 8 * fq;
        const bf16_t* gtb = W_GT2 + (size_t)l * 16 * D + cb; const bf16_t* gcb = W_GQ2 + (size_t)l * 16 * D + cb; const bf16_t* gnb = W_GQ1 + (size_t)((l + 1) & 3) * 16 * D + cb;
#pragma unroll
        for (int ai = 0; ai < 2; ++ai)
#pragma unroll
            for (int m = 0; m < 4; ++m) {
                if (!unit_on(u.q, ai, wr)) continue;
                const int rl = 128 * ai + 64 * wr + 16 * m + fr; const bool valid = rl < u.rcnt;
                const int tok = tokl[rl]; const int bo = (tok >> 11) * D;
                float ss = 0.f;
#pragma unroll
                for (int bj = 0; bj < 2; ++bj) {
                    const size_t off = (size_t)tok * D + cb + 128 * bj;
                    float xo[8], gt[8], gc[8], n[8];
                    unpack8(*(const u32x4*)(W_XG + off), xo); unpack8(*(const u32x4*)(gtb + bo + 128 * bj), gt); unpack8(*(const u32x4*)(gcb + bo + 128 * bj), gc);
#pragma unroll
                    for (int j = 0; j < 8; ++j) { n[j] = xo[j] * __builtin_amdgcn_rcpf(gc[j]) + gt[j] * acc[ai][bj][m][j >> 2][j & 3]; ss += n[j] * n[j]; }
                    if (l < DEPTH - 1) {
                        float gn[8]; unpack8(*(const u32x4*)(gnb + bo + 128 * bj), gn);
#pragma unroll
                        for (int j = 0; j < 8; ++j) n[j] *= gn[j];
                        if (valid) *(u32x4*)(xgo + off) = pack8(n);
                    } else if (valid) { *(f32x4*)(oo + off) = (f32x4){n[0], n[1], n[2], n[3]}; *(f32x4*)(oo + off + 4) = (f32x4){n[4], n[5], n[6], n[7]}; }
                }
                ss += __shfl_xor(ss, 16); ss += __shfl_xor(ss, 32);
                if (fq == 0) red[rl * 4 + wc] = ss;
            }
        if (l < DEPTH - 1) {
            asm volatile("s_waitcnt lgkmcnt(0)" ::: "memory"); __builtin_amdgcn_s_barrier(); asm volatile("" ::: "memory");
            if (tid < u.rcnt && unit_on(u.q, tid >> 7, (tid >> 6) & 1)) { const f32x4 t = *(const LAS f32x4*)(red + tid * 4); po[(size_t)tokl[tid] * 4 + pn] = (t.x + t.y) + (t.z + t.w); }
        }
    }
};

template <class Epi, class Sched>
__device__ __forceinline__ void gemm_simple(LAS unsigned char* lds, const Sched& S, const Epi& E) {
    const int tid = opaque_tid(), wid = __builtin_amdgcn_readfirstlane(tid >> 6), lane = tid & 63, wr = wid >> 2, wc = wid & 3, fr = lane & 15, fq = lane >> 4;
    GUnit u;
    for (int it = 0; S.next(it, u); ++it) {
        unsigned ra[2][4], rb[2][2];
#pragma unroll
        for (int ai = 0; ai < 2; ++ai)
#pragma unroll
            for (int m = 0; m < 4; ++m) ra[ai][m] = (unsigned)unit_row(S, u, 128 * ai + 64 * wr + 16 * m + fr) * (unsigned)S.lda() + 8u * fq;
#pragma unroll
        for (int bj = 0; bj < 2; ++bj)
#pragma unroll
            for (int n = 0; n < 2; ++n) rb[bj][n] = (unsigned)(128 * bj + 32 * wc + perm32(16 * n + fr)) * (unsigned)S.ldb() + 8u * fq;
        Acc acc;
#pragma unroll
        for (int a = 0; a < 2; ++a)
#pragma unroll
            for (int b = 0; b < 2; ++b)
#pragma unroll
                for (int m = 0; m < 4; ++m)
#pragma unroll
                    for (int n = 0; n < 2; ++n) acc[a][b][m][n] = (f32x4){0.f, 0.f, 0.f, 0.f};
        const int nks = 2 * S.nk();
        { __syncthreads(); E.prep(u, lds, tid); __syncthreads(); }
#pragma unroll 1
        for (int ks = 0; ks < nks; ++ks) {
            if constexpr (Epi::HOOK) { if (ks == S.nk()) { const LAS float* rsl = (const LAS float*)(lds + MISC_OFF + 6144) + 64 * wr + fr;
#pragma unroll
                for (int a = 0; a < 2; ++a)
#pragma unroll
                    for (int m = 0; m < 4; ++m) { const float r = rsl[128 * a + 16 * m];
#pragma unroll
                        for (int b = 0; b < 2; ++b)
#pragma unroll
                            for (int n = 0; n < 2; ++n) acc[a][b][m][n] = acc[a][b][m][n] * r; } } }
            const bf16_t* Bp = ((ks >> 1) < S.ksplit() ? u.B0 : u.B1) + ks * 32;
            const bf16_t* Ap = S.A + ks * 32;
            bf16x8 av[2][4], bv[2][2];
#pragma unroll
            for (int ai = 0; ai < 2; ++ai)
#pragma unroll
                for (int m = 0; m < 4; ++m) av[ai][m] = *(const bf16x8*)(Ap + ra[ai][m]);
#pragma unroll
            for (int bj = 0; bj < 2; ++bj)
#pragma unroll
                for (int n = 0; n < 2; ++n) bv[bj][n] = *(const bf16x8*)(Bp + rb[bj][n]);
#pragma unroll
            for (int ai = 0; ai < 2; ++ai)
#pragma unroll
                for (int bj = 0; bj < 2; ++bj)
#pragma unroll
                    for (int m = 0; m < 4; ++m)
#pragma unroll
                        for (int n = 0; n < 2; ++n) acc[ai][bj][m][n] = __builtin_amdgcn_mfma_f32_16x16x32_bf16(bv[bj][n], av[ai][m], acc[ai][bj][m][n], 0, 0, 0);
        }
        E.run(acc, u, wr, wc, fr, fq, lds, tid);
    }
}

constexpr int HTB = 128 * 64 * 2;
__device__ __forceinline__ int lds_byte(int r, int c) { const int st = (r >> 4) * 2 + (c >> 5), rr = r & 15, cc = c & 31, ob = rr * 64 + cc * 2; return st * 1024 + (ob ^ (((ob >> 9) & 1) << 5)); }
__device__ __forceinline__ void stage_rc(int b, int& R, int& Cc) { const int st = b / 1024, sb = b % 1024, swz = sb ^ (((sb >> 9) & 1) << 5); R = (st >> 1) * 16 + swz / 64; Cc = (st & 1) * 32 + (swz % 64) / 2; }

template <class Epi, class Sched, bool AFTER_DRAIN, bool NARROW = false, bool TSPLIT = false>
__device__ __forceinline__ void gemm_pipe(LAS unsigned char* lds, const Sched& S, const Epi& E) {
    const int tid = opaque_tid(), wid = __builtin_amdgcn_readfirstlane(tid >> 6), lane = tid & 63, wr = wid >> 2, wc = wid & 3, fr = lane & 15, fq = lane >> 4;
    constexpr bool ALIGN_EPI = !AFTER_DRAIN;
    const unsigned ldsw = (unsigned)wid * 1024u;
    const int aoff = lds_byte(wr * 64 + fr, fq * 8), boff = lds_byte(wc * 32 + fr, fq * 8);
    GUnit cur, nxt;
    if (!S.next(0, cur)) return;
    unsigned vaC[2][2], vaN[2][2], vbC[2], vbN[2];
#define GP_VOFF(U, va, vb) do { int t2_ = tid; asm volatile("" : "+v"(t2_));   \
        int R0, C0, R1, C1; stage_rc(t2_ * 16, R0, C0); stage_rc(t2_ * 16 + 8192, R1, C1); const int Rb0 = (R0 & ~31) + perm32(R0 & 31), Rb1 = (R1 & ~31) + perm32(R1 & 31); \
        va[0][0] = ((unsigned)unit_row(S, U, R0) * (unsigned)S.lda() + (unsigned)C0) * 2u; va[0][1] = ((unsigned)unit_row(S, U, R1) * (unsigned)S.lda() + (unsigned)C1) * 2u; \
        va[1][0] = ((unsigned)unit_row(S, U, 128 + R0) * (unsigned)S.lda() + (unsigned)C0) * 2u; va[1][1] = ((unsigned)unit_row(S, U, 128 + R1) * (unsigned)S.lda() + (unsigned)C1) * 2u; \
        vb[0] = ((unsigned)Rb0 * (unsigned)S.ldb() + (unsigned)C0) * 2u; vb[1] = ((unsigned)Rb1 * (unsigned)S.ldb() + (unsigned)C1) * 2u; } while (0)
    GP_VOFF(cur, vaC, vbC);
#define GP_SA(b, h) (((b) * 2 + (h)) * HTB)
#define GP_SB(b, h) ((4 + (b) * 2 + (h)) * HTB)
#define GP_GLDS(gp, off) __builtin_amdgcn_global_load_lds((const unsigned*)(gp), (LAS unsigned*)(lds + (off)), 16, 0, 0)
#define GP_STAGE(bufoff, gbase, v0, v1) do { GP_GLDS((const char*)(gbase) + (v0), (bufoff) + ldsw); GP_GLDS((const char*)(gbase) + (v1), (bufoff) + ldsw + 8192); } while (0)
#define GP_APTR(U, t) ((const char*)S.A + (size_t)(t) * 128)
#define GP_BPTR(U, t, h) ((const char*)((t) < S.ksplit() ? (U).B0 : (U).B1) + (size_t)(t) * 128 + (size_t)(h) * 256 * (size_t)S.ldb())
#define GP_LDA(dst, b, h) do { _Pragma("unroll") for (int m = 0; m < 4; ++m) _Pragma("unroll") for (int k = 0; k < 2; ++k) dst[m][k] = *(const LAS bf16x8*)(lds + GP_SA(b, h) + aoff + m * 2048 + k * 1024); } while (0)
#define GP_LDB(dst, b, h) do { _Pragma("unroll") for (int n = 0; n < 2; ++n) _Pragma("unroll") for (int k = 0; k < 2; ++k) dst[n][k] = *(const LAS bf16x8*)(lds + GP_SB(b, h) + boff + n * 2048 + k * 1024); } while (0)
#define GP_MMA(ai, bj, At, Bt) do { if (NARROW && ((bj) != 0 || wc != 0)) break; if (TSPLIT && !((ai) ? on1 : on0)) break; __builtin_amdgcn_s_setprio(1); _Pragma("unroll") for (int m = 0; m < 4; ++m) _Pragma("unroll") for (int n = 0; n < 2; ++n) _Pragma("unroll") for (int k = 0; k < 2; ++k) \
        acc[ai][bj][m][n] = __builtin_amdgcn_mfma_f32_16x16x32_bf16(Bt[n][k], At[m][k], acc[ai][bj][m][n], 0, 0, 0); __builtin_amdgcn_s_setprio(0); } while (0)
#define GP_WAIT_V(n) asm volatile("s_waitcnt vmcnt(" #n ")" ::: "memory")
#define GP_WAIT_L(n) asm volatile("s_waitcnt lgkmcnt(" #n ")" ::: "memory")
#define GP_BAR __builtin_amdgcn_s_barrier()
#define GP_SCHED __builtin_amdgcn_sched_barrier(0)
    Acc acc;
#pragma unroll
    for (int a = 0; a < 2; ++a)
#pragma unroll
        for (int b = 0; b < 2; ++b)
#pragma unroll
            for (int m = 0; m < 4; ++m)
#pragma unroll
                for (int n = 0; n < 2; ++n) acc[a][b][m][n] = (f32x4){0.f, 0.f, 0.f, 0.f};
    bf16x8 At[4][2], B0[2][2], B1[2][2];
    GP_STAGE(GP_SB(0, 0), GP_BPTR(cur, 0, 0), vbC[0], vbC[1]); GP_STAGE(GP_SB(0, 1), GP_BPTR(cur, 0, 1), vbC[0], vbC[1]);
    GP_STAGE(GP_SA(0, 0), GP_APTR(cur, 0), vaC[0][0], vaC[0][1]); GP_STAGE(GP_SA(0, 1), GP_APTR(cur, 0), vaC[1][0], vaC[1][1]);
    if (wr == 1) GP_BAR;
    GP_WAIT_V(2); GP_BAR;
    GP_STAGE(GP_SB(1, 0), GP_BPTR(cur, 1, 0), vbC[0], vbC[1]); GP_STAGE(GP_SA(1, 0), GP_APTR(cur, 1), vaC[0][0], vaC[0][1]); GP_STAGE(GP_SB(1, 1), GP_BPTR(cur, 1, 1), vbC[0], vbC[1]);
    GP_WAIT_V(6); GP_BAR;
    int ui = 0;
    for (;;) {
        const bool has_next = S.next(ui + 1, nxt);
        if (has_next) { GP_VOFF(nxt, vaN, vbN); }
        else { nxt = cur; vaN[0][0] = vaC[0][0]; vaN[0][1] = vaC[0][1]; vaN[1][0] = vaC[1][0]; vaN[1][1] = vaC[1][1]; vbN[0] = vbC[0]; vbN[1] = vbC[1]; }
        const int nt = S.nk();
        E.prep(cur, lds, tid);
        const bool on0 = !TSPLIT || unit_on(cur.q, 0, wr), on1 = !TSPLIT || unit_on(cur.q, 1, wr);
        auto kiter = [&](int t) __attribute__((always_inline)) {
            const bool last = (t == nt - 2);
            const char* a2 = last ? GP_APTR(nxt, 0) : GP_APTR(cur, t + 2); const char* a3 = last ? GP_APTR(nxt, 1) : GP_APTR(cur, t + 3);
            const char* b20 = last ? GP_BPTR(nxt, 0, 0) : GP_BPTR(cur, t + 2, 0); const char* b21 = last ? GP_BPTR(nxt, 0, 1) : GP_BPTR(cur, t + 2, 1);
            const char* b30 = last ? GP_BPTR(nxt, 1, 0) : GP_BPTR(cur, t + 3, 0); const char* b31 = last ? GP_BPTR(nxt, 1, 1) : GP_BPTR(cur, t + 3, 1);
            const unsigned xa00 = last ? vaN[0][0] : vaC[0][0], xa01 = last ? vaN[0][1] : vaC[0][1], xa10 = last ? vaN[1][0] : vaC[1][0], xa11 = last ? vaN[1][1] : vaC[1][1];
            const unsigned xb0 = last ? vbN[0] : vbC[0], xb1 = last ? vbN[1] : vbC[1];
            GP_LDB(B0, 0, 0); GP_LDB(B1, 0, 1); GP_SCHED; GP_LDA(At, 0, 0); GP_STAGE(GP_SA(1, 1), GP_APTR(cur, t + 1), vaC[1][0], vaC[1][1]);
            GP_WAIT_V(8); GP_WAIT_L(0); GP_BAR; GP_MMA(0, 0, At, B0); GP_MMA(0, 1, At, B1); GP_BAR; GP_SCHED;
            GP_LDA(At, 0, 1); GP_STAGE(GP_SB(0, 0), b20, xb0, xb1); GP_STAGE(GP_SB(0, 1), b21, xb0, xb1); GP_STAGE(GP_SA(0, 0), a2, xa00, xa01);
            GP_WAIT_V(8); GP_WAIT_L(0); GP_BAR; GP_MMA(1, 0, At, B0); GP_MMA(1, 1, At, B1); GP_BAR; GP_SCHED;
            GP_LDB(B0, 1, 0); GP_LDB(B1, 1, 1); GP_SCHED; GP_LDA(At, 1, 0); GP_STAGE(GP_SA(0, 1), a2, xa10, xa11);
            GP_WAIT_V(8); GP_WAIT_L(0); GP_BAR; GP_MMA(0, 0, At, B0); GP_MMA(0, 1, At, B1); GP_BAR; GP_SCHED;
            GP_LDA(At, 1, 1); GP_STAGE(GP_SB(1, 0), b30, xb0, xb1); GP_STAGE(GP_SB(1, 1), b31, xb0, xb1); GP_STAGE(GP_SA(1, 0), a3, xa00, xa01);
            GP_WAIT_V(8); GP_WAIT_L(0); GP_BAR; GP_MMA(1, 0, At, B0); GP_MMA(1, 1, At, B1); GP_BAR; GP_SCHED;
        };
#pragma unroll 1
        for (int t = 0; t < nt; t += 2) {
            if constexpr (Epi::HOOK) { if (t == (nt >> 1)) { const LAS float* rsl = (const LAS float*)(lds + MISC_OFF + 6144) + 64 * wr + fr;
#pragma unroll
              for (int a = 0; a < 2; ++a)
#pragma unroll
                for (int m = 0; m < 4; ++m) { const float r = rsl[128 * a + 16 * m];
#pragma unroll
                    for (int b = 0; b < 2; ++b)
#pragma unroll
                        for (int n = 0; n < 2; ++n) acc[a][b][m][n] = acc[a][b][m][n] * r; } } }
            kiter(t);
        }
        if constexpr (ALIGN_EPI) { if (wr == 0) GP_BAR; }
        if constexpr (!AFTER_DRAIN) { int fr_e = fr, fq_e = fq, tid_e = tid; asm volatile("" : "+v"(fr_e), "+v"(fq_e), "+v"(tid_e));
            E.run(acc, cur, wr, wc, fr_e, fq_e, lds, tid_e); }
        if (!has_next) break;
#pragma unroll
        for (int a = 0; a < 2; ++a)
#pragma unroll
            for (int b = 0; b < 2; ++b)
#pragma unroll
                for (int m = 0; m < 4; ++m)
#pragma unroll
                    for (int n = 0; n < 2; ++n) acc[a][b][m][n] = (f32x4){0.f, 0.f, 0.f, 0.f};
        cur = nxt; vaC[0][0] = vaN[0][0]; vaC[0][1] = vaN[0][1]; vaC[1][0] = vaN[1][0]; vaC[1][1] = vaN[1][1]; vbC[0] = vbN[0]; vbC[1] = vbN[1]; ++ui;
        if constexpr (ALIGN_EPI) { if (wr == 1) GP_BAR; }
    }
    GP_WAIT_V(0);
    if constexpr (!ALIGN_EPI) { if (wr == 0) GP_BAR; }
    GP_BAR;
    if constexpr (AFTER_DRAIN) { E.run(acc, cur, wr, wc, fr, fq, lds, tid); }
#undef GP_VOFF
#undef GP_SA
#undef GP_SB
#undef GP_GLDS
#undef GP_STAGE
#undef GP_APTR
#undef GP_BPTR
#undef GP_LDA
#undef GP_LDB
#undef GP_MMA
#undef GP_WAIT_V
#undef GP_WAIT_L
#undef GP_BAR
#undef GP_SCHED
}

__device__ __forceinline__ void tr_item(const float* W, int N, int k0, int n0, bf16_t* dst  , int ldd, LAS float* scr, int lane, const float* ksc = nullptr  ) {
    { f32x4 v[8]; const int n4 = (lane & 7) * 4;
#pragma unroll
      for (int i = 0; i < 8; ++i) v[i] = *(const f32x4*)(W + (size_t)(k0 + 8 * i + (lane >> 3)) * N + n0 + n4);
#pragma unroll
      for (int i = 0; i < 8; ++i) { const int kk = 8 * i + (lane >> 3); const float sc = ksc ? ksc[kk] : 1.f; LAS float* d = scr + kk * 33 + n4;
          d[0] = v[i].x * sc; d[1] = v[i].y * sc; d[2] = v[i].z * sc; d[3] = v[i].w * sc; } }
    asm volatile("s_waitcnt lgkmcnt(0)" ::: "memory");
    const int c = lane & 7;
#pragma unroll
    for (int j = 0; j < 4; ++j) { const int n = (lane >> 3) + 8 * j; const LAS float* s = scr + (8 * c) * 33 + n;
        u32x4 o; o.x = cvtpk(s[0 * 33], s[1 * 33]); o.y = cvtpk(s[2 * 33], s[3 * 33]); o.z = cvtpk(s[4 * 33], s[5 * 33]); o.w = cvtpk(s[6 * 33], s[7 * 33]);
        *(u32x4*)(dst + (size_t)n * ldd + 8 * c) = o; }
    asm volatile("s_waitcnt lgkmcnt(0)" ::: "memory");
}

__device__ __forceinline__ void phase_pa(const Ctx& C, LAS unsigned char* lds) {
    const int tid = opaque_tid(), lane = tid & 63, wave = __builtin_amdgcn_readfirstlane(tid >> 6);
    for (int item = blockIdx.x; item < 96; item += C.G) {
        const int l = item / 24, n0 = (item % 24) * 256;
        LAS float* cact = (LAS float*)lds;
        for (int i = tid; i < 16 * 1024; i += NTHR) { const int b = i >> 10, k = i & 1023; const float c = I_c[b * 1024 + k]; cact[k * 16 + b] = silu_f(c); }
        __syncthreads();
        f32x4 acc[16];
#pragma unroll
        for (int b = 0; b < 16; ++b) acc[b] = (f32x4){0.f, 0.f, 0.f, 0.f};
        const float* W = I_w_ada + ((size_t)l * 1024 + wave * 128) * 6144 + n0 + 4 * lane;
#pragma unroll 1
        for (int k = 0; k < 128; k += 4) {
            f32x4 w[4];
#pragma unroll
            for (int j = 0; j < 4; ++j) w[j] = *(const f32x4*)(W + (size_t)(k + j) * 6144);
#pragma unroll
            for (int j = 0; j < 4; ++j) {
                const LAS f32x4* cv = (const LAS f32x4*)(cact + (wave * 128 + k + j) * 16);
#pragma unroll
                for (int q = 0; q < 4; ++q) { const f32x4 cc = cv[q]; acc[4 * q + 0] += cc.x * w[j]; acc[4 * q + 1] += cc.y * w[j]; acc[4 * q + 2] += cc.z * w[j]; acc[4 * q + 3] += cc.w * w[j]; }
            }
        }
        __syncthreads();
        LAS float* red = (LAS float*)lds;
#pragma unroll
        for (int b = 0; b < 16; ++b) *(LAS f32x4*)(red + (wave * 16 + b) * 256 + 4 * lane) = acc[b];
        __syncthreads();
        for (int o = tid; o < 4096; o += NTHR) { const int b = o >> 8, ci = o & 255; float s = 0.f;
#pragma unroll
            for (int w = 0; w < 8; ++w) s += red[(w * 16 + b) * 256 + ci];
            W_MOD[(size_t)(l * 16 + b) * 6144 + n0 + ci] = s + I_b_ada[l * 6144 + n0 + ci]; }
        __syncthreads();
    }
    LAS float* scr = (LAS float*)(lds + wave * 16384);
    int it_lo, it_hi, it_first, it_step;
    { const int gw = blockIdx.x * NWAVES + wave, NGW = C.G * NWAVES;
      if (C.G == 256) { if (blockIdx.x < 96) { it_lo = 0; it_hi = 3840; it_first = gw; it_step = 768; } else { it_lo = 3840; it_hi = 8192 * DEPTH; it_first = 3840 + gw - 768; it_step = 1280; } }
      else { it_lo = 0; it_hi = 8192 * DEPTH; it_first = gw; it_step = NGW; } }
    (void)it_lo;
    for (int it = it_first; it < it_hi; it += it_step) {
        const int l = it >> 13; int r = it & 8191;
        if (r < 1536) { const int kb = r / 96, nb = r % 96, n0 = 32 * nb;
            const int drow = (n0 >= 1536 && n0 < 2560) ? (n0 & ~255) + 128 * ((n0 >> 5) & 1) + 32 * ((n0 >> 6) & 3) : n0;
            tr_item(I_w_in + (size_t)l * D * INW, INW, 64 * kb, n0, W_WIN + ((size_t)l * INW + drow) * D + 64 * kb, D, scr, lane); continue; }
        r -= 1536;
        if (r < 512) { const int kb = r / 32, nb = r % 32, k0 = 64 * kb;
            tr_item(I_w_out + (size_t)l * D * D, D, k0, 32 * nb, W_WOUT + ((size_t)l * D + 32 * nb) * D + ((k0 + 512) & 1023), D, scr, lane, k0 >= 512 ? I_attn_out_g + l * AW + (k0 - 512) : nullptr); continue; }
        r -= 512;
        if (r < 4096) { const int gu = r >> 11; r &= 2047; const int e = r >> 7, rr = r & 127, kb = rr / 8, nb = rr % 8, n0 = 32 * nb;
            const float* src = (gu ? I_w_up : I_w_gate) + (size_t)(l * 16 + e) * D * FF;
            bf16_t* dst = W_WGU + ((size_t)(((l * 16 + e) * 2 + (n0 >> 7)) * 2 + gu) * 128 + (n0 & 127)) * D + 64 * kb;
            tr_item(src, FF, 64 * kb, n0, dst, D, scr, lane); continue; }
        r -= 4096;
        { const int e = r >> 7, rr = r & 127, kb = rr / 32, nb = rr % 32;
          tr_item(I_w_down + (size_t)(l * 16 + e) * FF * D, D, 64 * kb, 32 * nb, W_WD + ((size_t)(l * 16 + e) * D + 32 * nb) * FF + 64 * kb, FF, scr, lane); }
    }
    const int gt = blockIdx.x * NTHR + tid, NGT = C.G * NTHR;
    for (int i = gt; i < DEPTH * 256 * 1024; i += NGT) {
        const int l = i >> 18, j = (i >> 10) & 255, k = i & 1023; float v = 0.f;
        if (j < 4) v = I_w_rg[((size_t)l * 1024 + k) * 4 + j]; else if (j < 32 && (j & 4)) v = I_w_re[((size_t)l * 1024 + k) * 16 + 4 * (j >> 3) + (j & 3)];
        W_WR[i] = f2bf(v);
    }
}

__device__ __forceinline__ void phase_pa2(const Ctx& C) {
    const int tid = opaque_tid(), lane = tid & 63, wave = __builtin_amdgcn_readfirstlane(tid >> 6);
    const int gt = blockIdx.x * NTHR + tid, NGT = C.G * NTHR;
    for (int i = gt; i < DEPTH * 16 * 1024; i += NGT) {
        const int l = i >> 14, b = (i >> 10) & 15, k = i & 1023; const float* m = W_MOD + (size_t)(l * 16 + b) * 6144;
        const unsigned short q1 = f2bf(I_norm1_g[l * 1024 + k] * (1.f + m[1024 + k])), q2 = f2bf(I_norm2_g[l * 1024 + k] * (1.f + m[4096 + k]));
        const float g1_ = __uint_as_float((unsigned)q1 << 16), g2_ = __uint_as_float((unsigned)q2 << 16);
        W_GM1[i] = g1_; W_GM2[i] = g2_; W_IGM1[i] = __builtin_amdgcn_rcpf(g1_); W_IGM2[i] = __builtin_amdgcn_rcpf(g2_);
        W_GQ1[i] = q1; W_GQ2[i] = q2; W_GT2[i] = f2bf(m[5120 + k]);
        W_SH[(size_t)((l * 2 + 0) * 16 + b) * 1024 + k] = f2bf(m[k]); W_SH[(size_t)((l * 2 + 1) * 16 + b) * 1024 + k] = f2bf(m[3072 + k]);
    }
    const int gw = blockIdx.x * NWAVES + wave, NGW = C.G * NWAVES;
    for (int tok0 = 2 * gw; tok0 < NTOK; tok0 += 2 * NGW) {
        f32x4 v[2][4];
#pragma unroll
        for (int r = 0; r < 2; ++r)
#pragma unroll
            for (int j = 0; j < 4; ++j) v[r][j] = *(const f32x4*)(I_x + (size_t)(tok0 + r) * D + 4 * lane + 256 * j);
#pragma unroll
        for (int r = 0; r < 2; ++r) {
            const int tok = tok0 + r, b = tok >> 11; const float* sc = W_MOD + (size_t)b * 6144 + 1024;
            float ss = 0.f;
#pragma unroll
            for (int j = 0; j < 4; ++j) {
                const int k = 4 * lane + 256 * j; const f32x4 x = v[r][j], g = *(const f32x4*)(I_norm1_g + k), s = *(const f32x4*)(sc + k);
                ss += (x.x * x.x + x.y * x.y) + (x.z * x.z + x.w * x.w);
                f32x4 gq = g * (s + 1.f); gq.x = bflo(cvtpk(gq.x, 0.f)); gq.y = bflo(cvtpk(gq.y, 0.f)); gq.z = bflo(cvtpk(gq.z, 0.f)); gq.w = bflo(cvtpk(gq.w, 0.f));
                const f32x4 o = x * gq;
                u32x2 w; w.x = cvtpk(o.x, o.y); w.y = cvtpk(o.z, o.w); *(u32x2*)(W_XG + (size_t)tok * D + k) = w;
            }
            ss = wave_sum(ss);
            if (lane < 4) W_PART1[(size_t)tok * 4 + lane] = lane == 0 ? ss : 0.f;
        }
    }
}

__device__ __forceinline__ void phase_t2(const Ctx& C, int l, int convreps) {
    const int tid = opaque_tid(), lane = tid & 63, gw = blockIdx.x * NWAVES + __builtin_amdgcn_readfirstlane(tid >> 6), NGW = C.G * NWAVES;
    for (int cr_ = 0; cr_ < convreps; ++cr_)
    for (int run = gw; run < NTOK / 16; run += NGW) {
        const int t0 = run * 16, ch0 = lane * 8;
        float cw0[8], cw1[8], cw2[8], og[8];
#pragma unroll
        for (int j = 0; j < 8; ++j) { cw0[j] = I_conv_w[(l * 3 + 0) * CW + ch0 + j]; cw1[j] = I_conv_w[(l * 3 + 1) * CW + ch0 + j]; cw2[j] = I_conv_w[(l * 3 + 2) * CW + ch0 + j]; og[j] = I_conv_out_g[l * CW + ch0 + j]; }
        float g1[8], g2[8];
#pragma unroll
        for (int j = 0; j < 8; ++j) { g1[j] = 0.f; g2[j] = 0.f; }
        if ((t0 & (SEQ - 1)) != 0) {
            float a[8], b[8];
            unpack8(*(const u32x4*)(W_UBCH + (size_t)(t0 - 2) * 1536 + 512 + ch0), a); unpack8(*(const u32x4*)(W_UBCH + (size_t)(t0 - 2) * 1536 + 1024 + ch0), b);
#pragma unroll
            for (int j = 0; j < 8; ++j) g2[j] = a[j] * b[j];
            unpack8(*(const u32x4*)(W_UBCH + (size_t)(t0 - 1) * 1536 + 512 + ch0), a); unpack8(*(const u32x4*)(W_UBCH + (size_t)(t0 - 1) * 1536 + 1024 + ch0), b);
#pragma unroll
            for (int j = 0; j < 8; ++j) g1[j] = a[j] * b[j];
        }
#pragma unroll 2
        for (int t = t0; t < t0 + 16; ++t) {
            float ub[8], uc[8], uh[8], y[8];
            const bf16_t* row = W_UBCH + (size_t)t * 1536 + ch0;
            unpack8(*(const u32x4*)(row), ub); unpack8(*(const u32x4*)(row + 512), uc); unpack8(*(const u32x4*)(row + 1024), uh);
            float ss = 0.f;
#pragma unroll
            for (int j = 0; j < 8; ++j) { const float g = uc[j] * uh[j]; y[j] = ub[j] * (cw0[j] * g2[j] + cw1[j] * g1[j] + cw2[j] * g); ss += y[j] * y[j]; g2[j] = g1[j]; g1[j] = g; }
            ss = wave_sum(ss);
            const float r = 1.0f / sqrtf(ss * (1.f / CW) + EPS);
#pragma unroll
            for (int j = 0; j < 8; ++j) y[j] = y[j] * r * og[j];
            *(u32x4*)(W_YMIX + (size_t)t * D + 512 + ch0) = pack8(y);
        }
    }
}

__device__ __forceinline__ void phase_attn_naive(const Ctx& C) {
    const int tid = opaque_tid(), lane = tid & 63, gw = blockIdx.x * NWAVES + __builtin_amdgcn_readfirstlane(tid >> 6), NGW = C.G * NWAVES;
    for (int item = gw; item < NB * NH * SEQ; item += NGW) {
        const int q = item & (SEQ - 1), h = (item >> 11) & 7, b = item >> 14, own = q >> 8, tok = b * SEQ + q;
        float qv[64];
        { const bf16_t* qp = W_Q + (size_t)tok * 512 + h * 64;
#pragma unroll
          for (int j = 0; j < 8; ++j) { float t[8]; unpack8(*(const u32x4*)(qp + 8 * j), t);
#pragma unroll
              for (int i = 0; i < 8; ++i) qv[8 * j + i] = t[i]; } }
        float gs; { const float* km = W_KMEAN + ((size_t)((b * NH + h) * NBLK + (lane & 7))) * 2 * HD; float s = 0.f;
#pragma unroll
            for (int d = 0; d < 64; ++d) s += qv[d] * (km[d] + km[64 + d]);
            gs = s; }
        float gsc[8];
#pragma unroll
        for (int j = 0; j < 8; ++j) gsc[j] = (j < own) ? __shfl(gs, j) : -INFINITY;
        unsigned sel = 0; const int nsel = own < 3 ? own : 3;
        for (int s = 0; s < nsel; ++s) { int bi = -1; float bv = -INFINITY;
#pragma unroll
            for (int j = 0; j < 8; ++j) if (j < own && !((sel >> j) & 1u) && (bi < 0 || gsc[j] > bv)) { bv = gsc[j]; bi = j; }
            sel |= 1u << bi; }
        float mrun = -INFINITY, lrun = 0.f, oacc = 0.f;
        for (int jb = 0; jb <= own; ++jb) {
            if (jb < own && !((sel >> jb) & 1u)) continue;
            for (int kk = 0; kk < 4; ++kk) {
                const int key = jb * 256 + kk * 64 + lane; const bf16_t* kp = W_K + (size_t)(b * SEQ + key) * 512 + h * 64;
                float s = 0.f;
#pragma unroll
                for (int j = 0; j < 8; ++j) { float t[8]; unpack8(*(const u32x4*)(kp + 8 * j), t);
#pragma unroll
                    for (int i = 0; i < 8; ++i) s += qv[8 * j + i] * t[i]; }
                if (jb == own && key > q) s = -INFINITY;
                const float cm = wave_max(s);
                if (cm == -INFINITY) continue;
                const float mn = fmaxf(mrun, cm), scl = exp2f(mrun - mn), p = exp2f(s - mn);
                lrun = lrun * scl + wave_sum(p); oacc *= scl; mrun = mn;
                const bf16_t* vp = W_V + (size_t)(b * SEQ + jb * 256 + kk * 64) * 512 + h * 64 + lane;
#pragma unroll 8
                for (int j = 0; j < 64; ++j) { const float pj = __shfl(p, j); oacc += pj * __uint_as_float((unsigned)vp[(size_t)j * 512] << 16); }
            }
        }
        W_YATT[(size_t)tok * 512 + h * 64 + lane] = f2bf(oacc / lrun);
    }
}

namespace attn_body {
typedef unsigned short bf16;
using bf16x8=__attribute__((ext_vector_type(8)))short;
using s16x4=__attribute__((ext_vector_type(4)))short;
using f32x16=__attribute__((ext_vector_type(16)))float;
using u32x4=__attribute__((ext_vector_type(4)))unsigned;
constexpr int BATCH=16,NHEAD=8,SEQ=2048,D=64,DM=NHEAD*D;
constexpr int NW=8,QBLK=32,QB=QBLK*NW,KVBLK=64,NQB=SEQ/QB;
constexpr int ATTN_PITCH=DM, ATTN_UNIT_ROWS=QB;
__device__ __forceinline__ int crow(int r,int hi){return (r&3)+8*(r>>2)+4*hi;}
#define SBAR() __builtin_amdgcn_sched_barrier(0)
__device__ __forceinline__ void cmask(f32x16&p0,f32x16&p1,int jb,int qrel,int hi){
  const float NEG=-INFINITY; int kb=64*jb+4*hi;
  #pragma unroll
  for(int r=0;r<16;++r){int kv=kb+(r&3)+8*(r>>2); if(kv>qrel)p0[r]=NEG; if(kv+32>qrel)p1[r]=NEG;}
}

constexpr int NSLOT=3, SLOTB=8192;
constexpr int LDS_K=0, LDS_V=NSLOT*SLOTB, LDS_WS=2*NSLOT*SLOTB, LDS_OST=LDS_WS+NW*64*4, LDS_BYTES=LDS_OST+NW*4096;
constexpr float C2=0.125f*1.4426950408889634f;
__device__ __forceinline__ void glds16(const void*gsrc,unsigned lds_dst){unsigned keep;
  asm volatile("s_mov_b32 %0, m0\n\ts_mov_b32 m0, %2\n\ts_nop 0\n\tglobal_load_lds_dwordx4 %1, off\n\ts_mov_b32 m0, %0":"=&s"(keep):"v"(gsrc),"s"(lds_dst):"memory");}
__device__ __forceinline__ float max3f(float a,float b,float c){float r;asm("v_max3_f32 %0, %1, %2, %3":"=v"(r):"v"(a),"v"(b),"v"(c));return r;}
__device__ __forceinline__ float max2f(float a,float b){float r;asm("v_max_f32_e32 %0, %1, %2":"=v"(r):"v"(a),"v"(b));return r;}
__device__ __forceinline__ float fadd_s(float a,float b){float r;asm("v_add_f32_e32 %0, %1, %2":"=v"(r):"v"(a),"v"(b));return r;}
__device__ __forceinline__ float fsub_s(float a,float b){float r;asm("v_sub_f32_e32 %0, %1, %2":"=v"(r):"v"(a),"v"(b));return r;}
typedef float f32x2_t __attribute__((ext_vector_type(2))); typedef __bf16 bf16x2_t __attribute__((ext_vector_type(2)));
__device__ __forceinline__ unsigned cvtpk_s(float lo,float hi){f32x2_t v={lo,hi};bf16x2_t b=__builtin_convertvector(v,bf16x2_t);return __builtin_bit_cast(unsigned,b);}
#define WAIT_BAR(N) asm volatile("s_waitcnt vmcnt(" #N ") lgkmcnt(0)\n\ts_barrier":::"memory")

__device__ __forceinline__ void qkt(f32x16&p0,f32x16&p1,const char*Kslot,const bf16x8*qr,const f32x16&negm,int r32,int hi){
  const char*kb=Kslot+hi*1024+r32*16;
  #pragma unroll
  for(int d0=0;d0<4;++d0){
    const bf16x8 b0=*reinterpret_cast<const bf16x8*>(kb+d0*2048);
    const bf16x8 b1=*reinterpret_cast<const bf16x8*>(kb+d0*2048+512);
    if(d0==0){p0=__builtin_amdgcn_mfma_f32_32x32x16_bf16(b0,qr[0],negm,0,0,0);p1=__builtin_amdgcn_mfma_f32_32x32x16_bf16(b1,qr[0],negm,0,0,0);}
    else{p0=__builtin_amdgcn_mfma_f32_32x32x16_bf16(b0,qr[d0],p0,0,0,0);p1=__builtin_amdgcn_mfma_f32_32x32x16_bf16(b1,qr[d0],p1,0,0,0);}}
}
typedef __attribute__((address_space(3))) const char* lds_cptr;
typedef short v4i16_t __attribute__((ext_vector_type(4)));
__device__ __forceinline__ void kload8(bf16x8*kf,lds_cptr kp){
  kf[0]=*(const __attribute__((address_space(3))) bf16x8*)(kp);      kf[1]=*(const __attribute__((address_space(3))) bf16x8*)(kp+512);
  kf[2]=*(const __attribute__((address_space(3))) bf16x8*)(kp+2048); kf[3]=*(const __attribute__((address_space(3))) bf16x8*)(kp+2560);
  kf[4]=*(const __attribute__((address_space(3))) bf16x8*)(kp+4096); kf[5]=*(const __attribute__((address_space(3))) bf16x8*)(kp+4608);
  kf[6]=*(const __attribute__((address_space(3))) bf16x8*)(kp+6144); kf[7]=*(const __attribute__((address_space(3))) bf16x8*)(kp+6656);
}
__device__ __forceinline__ void kload2(bf16x8*kf,lds_cptr kp,int j){ kf[2*j]=*(const __attribute__((address_space(3))) bf16x8*)(kp+j*2048); kf[2*j+1]=*(const __attribute__((address_space(3))) bf16x8*)(kp+j*2048+512); }
__device__ __forceinline__ s16x4 vtr(lds_cptr p){ return __builtin_bit_cast(s16x4,__builtin_amdgcn_ds_read_tr16_b64_v4i16((__attribute__((address_space(3))) v4i16_t*)p)); }
__device__ __forceinline__ float rowmax(const f32x16&p0,const f32x16&p1){
  float a=max3f(p0[0],p0[1],p1[0]),b=max3f(p0[2],p0[3],p1[1]);a=max3f(a,p1[2],p1[3]);
  #pragma unroll
  for(int r=4;r<16;r+=4){a=max3f(a,p0[r],p0[r+1]);b=max3f(b,p0[r+2],p0[r+3]);a=max3f(a,p1[r],p1[r+1]);b=max3f(b,p1[r+2],p1[r+3]);}
  const float m=max2f(a,b);
  auto rr=__builtin_amdgcn_permlane32_swap(__float_as_uint(m),__float_as_uint(m),false,false);
  return max2f(__uint_as_float(rr[0]),__uint_as_float(rr[1]));
}
__device__ __forceinline__ void pv(f32x16*o,int vb,bf16x8 pa0,bf16x8 pa1,bf16x8 pa2,bf16x8 pa3){
  #pragma unroll
  for(int d0=0;d0<2;++d0){s16x4 lo[4],hi[4];
    #pragma unroll
    for(int ks=0;ks<4;++ks){
      asm volatile("ds_read_b64_tr_b16 %0,%1 offset:%c2":"=&v"(lo[ks]):"v"(vb),"i"(d0*4096+ks*1024):"memory");
      asm volatile("ds_read_b64_tr_b16 %0,%1 offset:%c2":"=&v"(hi[ks]):"v"(vb),"i"(d0*4096+ks*1024+512):"memory");}
    asm volatile("s_waitcnt lgkmcnt(0)":::"memory");SBAR();
    #define PK(k) (bf16x8){lo[k][0],lo[k][1],lo[k][2],lo[k][3],hi[k][0],hi[k][1],hi[k][2],hi[k][3]}
    o[d0]=__builtin_amdgcn_mfma_f32_32x32x16_bf16(pa0,PK(0),o[d0],0,0,0);
    o[d0]=__builtin_amdgcn_mfma_f32_32x32x16_bf16(pa1,PK(1),o[d0],0,0,0);
    o[d0]=__builtin_amdgcn_mfma_f32_32x32x16_bf16(pa2,PK(2),o[d0],0,0,0);
    o[d0]=__builtin_amdgcn_mfma_f32_32x32x16_bf16(pa3,PK(3),o[d0],0,0,0);
    #undef PK
  }
}

#ifndef ATTN_STORE16
#define ATTN_STORE16(p,v) (*(u32x4*)(p)=(v))
#endif
template<int THRL> __device__ __forceinline__ void attn_unit(int b,int h,int qb,const bf16*Q,const bf16*__restrict__ K,const bf16*__restrict__ V,bf16*O,float*PA,const float*__restrict__ KM,char*shm){
  int tid_=threadIdx.x; asm volatile("":"+v"(tid_));
  const int tid=tid_,lane=tid&63,r32=lane&31,hi=lane>>5; const int wid=__builtin_amdgcn_readfirstlane(tid>>6);
  const long rowbase=(long)b*SEQ; const int q0=qb*QB;
  const bf16*Qw=Q+(rowbase+q0+wid*QBLK)*DM+h*D;
  const bf16*Kh=K+rowbase*DM+h*D,*Vh=V+rowbase*DM+h*D;
  const unsigned lds0=(unsigned)(uintptr_t)shm;
  float*wsf=(float*)(shm+LDS_WS)+wid*64;
  const bf16*ksrc=Kh+(long)lane*DM+wid*8;
  const bf16*vsrc=Vh+(long)(16*(wid&3)+(lane>>2))*DM+(wid>>2)*32+(lane&3)*8;
  const unsigned kdst=lds0+LDS_K+wid*1024, vdst=lds0+LDS_V+wid*1024;
  #define KT(t) (((t)<4)?(4*qb+(t)):((t)-4))
  #define DMA_K(t,slot) glds16(ksrc+(long)KT(t)*KVBLK*DM,(unsigned)__builtin_amdgcn_readfirstlane(kdst+(slot)))
  #define DMA_V(t,slot) glds16(vsrc+(long)KT(t)*KVBLK*DM,(unsigned)__builtin_amdgcn_readfirstlane(vdst+(slot)))
  const int vb0=(int)(lds0+LDS_V)+((lane>>4)&1)*32+(lane&3)*8+(4*hi+((lane&15)>>2))*64;
  const char*Kbase=shm+LDS_K; bf16x8 kf[8];
  const lds_cptr shm3=(lds_cptr)shm; const lds_cptr kp0=shm3+LDS_K+hi*1024+r32*16; const lds_cptr vp0=shm3+LDS_V+((lane>>4)&1)*32+(lane&3)*8+(4*hi+((lane&15)>>2))*64;
  const int NT=(q0+QB)/KVBLK;
  DMA_K(0,0);DMA_V(0,0);DMA_K(1,SLOTB);
  bf16x8 qr[4];
  #pragma unroll
  for(int d0=0;d0<4;++d0)qr[d0]=*reinterpret_cast<const bf16x8*>(&Qw[(long)r32*DM+d0*16+hi*8]);
  unsigned selm=0u;
  { float gs[7];
    #pragma unroll
    for(int j=0;j<7;++j){ float s=0.f;
      if(j<qb){ const float*km=KM+j*128+hi*8;
        #pragma unroll
        for(int d0=0;d0<4;++d0){ float4 k0=*reinterpret_cast<const float4*>(km+d0*16), k1=*reinterpret_cast<const float4*>(km+d0*16+4); { const float4 k2=*reinterpret_cast<const float4*>(km+64+d0*16), k3=*reinterpret_cast<const float4*>(km+64+d0*16+4); k0.x+=k2.x;k0.y+=k2.y;k0.z+=k2.z;k0.w+=k2.w;k1.x+=k3.x;k1.y+=k3.y;k1.z+=k3.z;k1.w+=k3.w; } const bf16x8 qq=qr[d0];
          s+=__uint_as_float(((unsigned)(unsigned short)qq[0])<<16)*k0.x+__uint_as_float(((unsigned)(unsigned short)qq[1])<<16)*k0.y+__uint_as_float(((unsigned)(unsigned short)qq[2])<<16)*k0.z+__uint_as_float(((unsigned)(unsigned short)qq[3])<<16)*k0.w
            +__uint_as_float(((unsigned)(unsigned short)qq[4])<<16)*k1.x+__uint_as_float(((unsigned)(unsigned short)qq[5])<<16)*k1.y+__uint_as_float(((unsigned)(unsigned short)qq[6])<<16)*k1.z+__uint_as_float(((unsigned)(unsigned short)qq[7])<<16)*k1.w; }
        s=s+__shfl_xor(s,32); }
      gs[j]=s; }
    if(qb<=3) selm=(1u<<qb)-1u;
    else{
      #pragma unroll
      for(int p=0;p<3;++p){ float best=-INFINITY; int bi=0;
        #pragma unroll
        for(int j=0;j<7;++j){ const bool ok=(j<qb)&&!((selm>>j)&1u)&&(gs[j]>best); best=ok?gs[j]:best; bi=ok?j:bi; }
        selm|=1u<<bi; } } }
  float mhat=0.f,l_reg=0.f,negm1=0.f;f32x16 o[2];o[0]=f32x16{};o[1]=f32x16{};
  const int qrel=wid*QBLK+r32;
  #define CMASK(P0,P1,t) do{const int t_=(t); if(t_<4){cmask(P0,P1,t_,qrel,hi);} }while(0)
  bool resc=false;
  #define START(P0,P1) do{ const float rm=rowmax(P0,P1); resc=false; \
    { const float dl=rm; mhat=fadd_s(mhat,dl); \
      _Pragma("unroll") for(int r=0;r<16;++r){P0[r]=fsub_s(P0[r],dl);P1[r]=fsub_s(P1[r],dl);} \
      negm1=-mhat; } \
    _Pragma("unroll") for(int r=0;r<16;++r)P0[r]=__builtin_amdgcn_exp2f(P0[r]); }while(0)
  #define RESC() do{ if(resc){ asm volatile("s_waitcnt lgkmcnt(0)":::"memory"); \
      _Pragma("unroll") for(int d_=0;d_<2;++d_) _Pragma("unroll") for(int r=0;r<16;++r)o[d_][r]*=wsf[crow(r,hi)]; } }while(0)
  f32x16 pA0,pA1,pB0,pB1;
  int sl_prev=0,sl_cur=0,sl_next=SLOTB;
  #define ROT() do{sl_prev=sl_cur;sl_cur=sl_next;sl_next=(sl_next==(NSLOT-1)*SLOTB)?0:sl_next+SLOTB;}while(0)
  DMA_K(2,2*SLOTB);
  WAIT_BAR(3);
  qkt(pA0,pA1,Kbase,qr,f32x16{},r32,hi);asm volatile("s_nop 15\n\ts_nop 7":"+v"(pA0),"+v"(pA1));CMASK(pA0,pA1,0);
  START(pA0,pA1);
  _Pragma("unroll") for(int r=0;r<16;++r)pA1[r]=__builtin_amdgcn_exp2f(pA1[r]);
  WAIT_BAR(0);
  DMA_K(3,0);DMA_V(1,SLOTB);
  ROT();
  kload8(kf,kp0+sl_cur);
  WAIT_BAR(2);
  s16x4 vlo[8],vhi[8]; u32x4 pw0,pw1,pw2,pw3;
  #define PKW(P,B) cvtpk_s(P[B],P[B+1])
  #define PAF(k) __builtin_bit_cast(bf16x8,pw##k)
  #define VFR(i) (bf16x8){vlo[i][0],vlo[i][1],vlo[i][2],vlo[i][3],vhi[i][0],vhi[i][1],vhi[i][2],vhi[i][3]}
  #define PIN(x) asm volatile("":"+v"(x))
  #define MX3(a,b,c) __builtin_fmaxf(__builtin_fmaxf((a),(b)),(c))
  #define GAPA(MF,A0,A1,A2,A3,W0,W1,PW) do{ MF; sacc+=A0; sacc+=A1; sacc+=A2; sacc+=A3; PIN(sacc); W0; W1; PIN(PW); SBAR(); }while(0)
  #define EX(v) __builtin_amdgcn_exp2f(v)
  #define GAPB(MF,X,B) do{ MF; X[B]=EX(X[B]); X[B+1]=EX(X[B+1]); X[B+2]=EX(X[B+2]); X[B+3]=EX(X[B+3]); PIN(X); SBAR(); }while(0)
  #define VRD(i) do{ vlo[i]=vtr(vp_+(((i)>>2)*4096+((i)&3)*1024)); vhi[i]=vtr(vp_+(((i)>>2)*4096+((i)&3)*1024+512)); }while(0)
  #define KRD(G,j) do{ if(G){ kload2(kf,kp0+sl_next,j); SBAR(); } }while(0)
  #define STEP(C0,C1,P0,P1,t,GK,GV,GL) do{ SBAR(); \
    const lds_cptr vp_=vp0+sl_prev; \
    const float cv_=(((t)<4)||((selm>>(((t)-4)>>2))&1u))?negm1:-INFINITY; _Pragma("unroll") for(int r=0;r<16;++r){C0[r]=cv_;C1[r]=cv_;} PIN(C0); PIN(C1); \
    VRD(0); SBAR(); float sacc=(P0[0]+P0[1]); \
    GAPA(C0=__builtin_amdgcn_mfma_f32_32x32x16_bf16(kf[0],qr[0],C0,0,0,0), P0[2],P0[3],P0[4],P0[5],     pw0[0]=PKW(P0,0), pw0[1]=PKW(P0,2), pw0); \
    VRD(4); SBAR(); GAPA(C1=__builtin_amdgcn_mfma_f32_32x32x16_bf16(kf[1],qr[0],C1,0,0,0), P0[6],P0[7],P0[8],P0[9],     pw0[2]=PKW(P0,4), pw0[3]=PKW(P0,6), pw0); \
    VRD(1); SBAR(); GAPA(C0=__builtin_amdgcn_mfma_f32_32x32x16_bf16(kf[2],qr[1],C0,0,0,0),   P0[10],P0[11],P0[12],P0[13], pw1[0]=PKW(P0,8), pw1[1]=PKW(P0,10), pw1); \
    VRD(5); SBAR(); GAPA(C1=__builtin_amdgcn_mfma_f32_32x32x16_bf16(kf[3],qr[1],C1,0,0,0),   P0[14],P0[15],P1[0],P1[1],   pw1[2]=PKW(P0,12),pw1[3]=PKW(P0,14), pw1); \
    VRD(2); SBAR(); GAPA(C0=__builtin_amdgcn_mfma_f32_32x32x16_bf16(kf[4],qr[2],C0,0,0,0),   P1[2],P1[3],P1[4],P1[5],     pw2[0]=PKW(P1,0), pw2[1]=PKW(P1,2), pw2); \
    VRD(6); SBAR(); GAPA(C1=__builtin_amdgcn_mfma_f32_32x32x16_bf16(kf[5],qr[2],C1,0,0,0),   P1[6],P1[7],P1[8],P1[9],     pw2[2]=PKW(P1,4), pw2[3]=PKW(P1,6), pw2); \
    VRD(3); SBAR(); GAPA(C0=__builtin_amdgcn_mfma_f32_32x32x16_bf16(kf[6],qr[3],C0,0,0,0),   P1[10],P1[11],P1[12],P1[13], pw3[0]=PKW(P1,8), pw3[1]=PKW(P1,10), pw3); \
    VRD(7); SBAR(); GAPA(C1=__builtin_amdgcn_mfma_f32_32x32x16_bf16(kf[7],qr[3],C1,0,0,0),   P1[14],P1[15],0.f,0.f,       pw3[2]=PKW(P1,12),pw3[3]=PKW(P1,14), pw3); \
    l_reg+=sacc; \
    if(GK){DMA_K((t)+3,sl_cur);} if(GV){DMA_V((t)+1,sl_next);} \
    CMASK(C0,C1,t); \
    { float a=MX3(C0[0],C0[1],C1[0]),b=MX3(C0[2],C0[3],C1[1]); a=MX3(a,C1[2],C1[3]); \
      _Pragma("unroll") for(int r=4;r<16;r+=4){a=MX3(a,C0[r],C0[r+1]);b=MX3(b,C0[r+2],C0[r+3]);a=MX3(a,C1[r],C1[r+1]);b=MX3(b,C1[r+2],C1[r+3]);} \
      float rm=__builtin_fmaxf(a,b); { auto rr=__builtin_amdgcn_permlane32_swap(__float_as_uint(rm),__float_as_uint(rm),false,false); rm=__builtin_fmaxf(__uint_as_float(rr[0]),__uint_as_float(rr[1])); } \
      resc=false; \
      if(__builtin_expect(__any(rm>(float)THRL),0)){ const float dl=__builtin_fmaxf(rm,0.f); mhat+=dl; \
        _Pragma("unroll") for(int r=0;r<16;++r){C0[r]-=dl;C1[r]-=dl;} \
        negm1=-mhat; \
        const float f=__builtin_amdgcn_exp2f(-dl); l_reg*=f; if(hi==0)wsf[r32]=f; resc=true; } } \
    SBAR(); \
    GAPB(o[0]=__builtin_amdgcn_mfma_f32_32x32x16_bf16(PAF(0),VFR(0),o[0],0,0,0), C0,0); \
    GAPB(o[1]=__builtin_amdgcn_mfma_f32_32x32x16_bf16(PAF(0),VFR(4),o[1],0,0,0), C0,4); \
    KRD(GL,0); GAPB(o[0]=__builtin_amdgcn_mfma_f32_32x32x16_bf16(PAF(1),VFR(1),o[0],0,0,0), C0,8); \
    KRD(GL,1); GAPB(o[1]=__builtin_amdgcn_mfma_f32_32x32x16_bf16(PAF(1),VFR(5),o[1],0,0,0), C0,12); \
    KRD(GL,2); GAPB(o[0]=__builtin_amdgcn_mfma_f32_32x32x16_bf16(PAF(2),VFR(2),o[0],0,0,0), C1,0); \
    KRD(GL,3); GAPB(o[1]=__builtin_amdgcn_mfma_f32_32x32x16_bf16(PAF(2),VFR(6),o[1],0,0,0), C1,4); \
    GAPB(o[0]=__builtin_amdgcn_mfma_f32_32x32x16_bf16(PAF(3),VFR(3),o[0],0,0,0), C1,8); \
    GAPB(o[1]=__builtin_amdgcn_mfma_f32_32x32x16_bf16(PAF(3),VFR(7),o[1],0,0,0), C1,12); \
    }while(0)
  int t=1;
  for(;t+5<NT;t+=2){
    STEP(pB0,pB1,pA0,pA1,t,true,true,true);     WAIT_BAR(2); RESC(); ROT();
    STEP(pA0,pA1,pB0,pB1,t+1,true,true,true);   WAIT_BAR(2); RESC(); ROT();
  }
  #define ENDW(tt) do{ if((tt)+3<NT){WAIT_BAR(2);} else if((tt)+2<NT){WAIT_BAR(1);} else {WAIT_BAR(0);} }while(0)
  for(;t+1<NT;t+=2){
    STEP(pB0,pB1,pA0,pA1,t,(t+3<NT),(t+1<NT),(t+1<NT));       ENDW(t);   RESC(); ROT();
    STEP(pA0,pA1,pB0,pB1,t+1,(t+4<NT),(t+2<NT),(t+2<NT));     ENDW(t+1); RESC(); ROT();
  }
  STEP(pB0,pB1,pA0,pA1,NT-1,false,false,false); RESC();
  { float sacc=pB0[0]+pB0[1]; _Pragma("unroll") for(int r=2;r<16;++r)sacc+=pB0[r]; _Pragma("unroll") for(int r=0;r<16;++r)sacc+=pB1[r]; l_reg+=sacc;
    pw0=(u32x4){PKW(pB0,0),PKW(pB0,2),PKW(pB0,4),PKW(pB0,6)};pw1=(u32x4){PKW(pB0,8),PKW(pB0,10),PKW(pB0,12),PKW(pB0,14)};pw2=(u32x4){PKW(pB1,0),PKW(pB1,2),PKW(pB1,4),PKW(pB1,6)};pw3=(u32x4){PKW(pB1,8),PKW(pB1,10),PKW(pB1,12),PKW(pB1,14)};
    SBAR(); pv(o,vb0+sl_cur,PAF(0),PAF(1),PAF(2),PAF(3)); }
  #undef PKW
  #undef PAF
  #undef VFR
  #undef PIN
  #undef MX3
  #undef GAPA
  #undef GAPB
  #undef EX
  #undef VRD
  #undef KRD
  #undef STEP
  #undef ENDW
  {auto rr=__builtin_amdgcn_permlane32_swap(__float_as_uint(l_reg),__float_as_uint(l_reg),false,false);l_reg=__uint_as_float(rr[0])+__uint_as_float(rr[1]);}
  if(hi==0)wsf[32+r32]=l_reg;asm volatile("s_waitcnt lgkmcnt(0)":::"memory");
  float rli[16];
  #pragma unroll
  for(int r=0;r<16;++r)rli[r]=__builtin_amdgcn_rcpf(wsf[32+crow(r,hi)]);
  constexpr int ODM=1024;
  bf16*Ow=O+(rowbase+q0+wid*QBLK)*ODM+h*D; float*PAw=PA+(rowbase+q0+wid*QBLK)*NHEAD+h;
  { bf16*stg=(bf16*)(shm+LDS_OST)+wid*2048;
    #pragma unroll
    for(int r=0;r<16;++r){const int orow=crow(r,hi);
      #pragma unroll
      for(int d0=0;d0<2;++d0)stg[orow*64+d0*32+r32]=(bf16)(cvtpk_s(o[d0][r]*rli[r],0.f)&0xffffu);}
    asm volatile("s_waitcnt lgkmcnt(0)":::"memory");
    #pragma unroll
    for(int i=0;i<4;++i){const int row=i*8+(lane>>3),ch=lane&7; const u32x4 v=*(const u32x4*)(stg+row*64+ch*8); ATTN_STORE16(Ow+(long)row*ODM+ch*8,v);
      float sq=0.f;
      #pragma unroll
      for(int e=0;e<4;++e){const float a0=__uint_as_float(v[e]<<16),a1=__uint_as_float(v[e]&0xffff0000u); sq+=a0*a0+a1*a1;}
      sq+=__shfl_xor(sq,1);sq+=__shfl_xor(sq,2);sq+=__shfl_xor(sq,4);
      if(ch==0)PAw[(long)row*NHEAD]=sq;} }
  asm volatile("s_waitcnt lgkmcnt(0)\n\ts_barrier":::"memory");
  #undef DMA_K
  #undef KT
  #undef DMA_V
  #undef CMASK
  #undef START
  #undef RESC
  #undef ROT
}
constexpr int ATTN_LDS_BYTES=LDS_BYTES;
template<int THRL=8> __device__ __forceinline__ void attn_phase(char*lds,const bf16*Q,const bf16*K,const bf16*V,bf16*O,float*PA,const float*KMEAN,int vcu,int G){
  for(int slot=vcu;slot<BATCH*NHEAD*2;slot+=G){ const int bh=slot>>1,s=slot&1;
    #pragma unroll 1
    for(int i=0;i<4;++i){ const int qb=(i==0)?(7-s):(i==1)?(5-s):(i==2)?(2+s):s;
      attn_unit<THRL>(bh/NHEAD,bh%NHEAD,qb,Q,K,V,O,PA,KMEAN+(long)bh*(SEQ/QB)*2*D,lds); } }
}
#undef SBAR
#undef WAIT_BAR
}

__device__ __forceinline__ void phase_t3(const Ctx& C, int l) {
    const int tid = opaque_tid(), lane = tid & 63, gw = blockIdx.x * NWAVES + __builtin_amdgcn_readfirstlane(tid >> 6), NGW = C.G * NWAVES;
    for (int tok = gw; tok < NTOK; tok += NGW) {
        float x[8]; unpack8(*(const u32x4*)(W_YATT + (size_t)tok * 512 + 8 * lane), x);
        float ss = 0.f;
#pragma unroll
        for (int j = 0; j < 8; ++j) ss += x[j] * x[j];
        ss = wave_sum(ss);
        const float r = 1.0f / sqrtf(ss * (1.f / AW) + EPS);
#pragma unroll
        for (int j = 0; j < 8; ++j) x[j] = x[j] * r * I_attn_out_g[l * AW + 8 * lane + j];
        *(u32x4*)(W_YMIX + (size_t)tok * D + 512 + 8 * lane) = pack8(x);
    }
}

__global__ void __launch_bounds__(NTHR, 2) fwd_kernel(Args args) {
    extern __shared__ __attribute__((aligned(16))) unsigned char lds_raw[];
    LAS unsigned char* lds = (LAS unsigned char*)lds_raw;
    Ctx C;
    C.a = &args; C.ws = args.ws; C.out = args.out;
    C.G = gridDim.x; C.tid = threadIdx.x; C.lane = C.tid & 63; C.wave = __builtin_amdgcn_readfirstlane(C.tid >> 6);
    { const int bx = blockIdx.x; C.vcu = (C.G % 8 == 0) ? (bx % 8) * (C.G / 8) + bx / 8 : bx; }

    volatile LAS unsigned* MISC = (volatile LAS unsigned*)(lds + MISC_OFF);
    for (int u = C.tid; u < (LDS_BYTES - MISC_OFF) / 4; u += NTHR) ((LAS unsigned*)(lds + MISC_OFF))[u] = 0u;
    __syncthreads();
    const int lo = args.ph_lo, hi = args.ph_hi;
    XcdBarrier bar; bar.bar = W_ctl + CW_BAR; bar.x = 0; bar.st = nullptr;
    if (hi - lo > 1) bar = xcd_barrier_post(W_ctl + CW_BAR, MISC + 8);
#ifndef PHM
#define PHM 0x7ff
#endif
#ifndef GPM
#define GPM 0x7ff
#endif
#ifndef DUPM
#define DUPM 0
#endif
#define REP(bit) for (int rep_ = 0; rep_ < (((DUPM) & (bit)) ? 2 : 1); ++rep_)
#define IN(k) (launder_ctx(C), lo <= (k) && (k) < hi)
#ifndef BARX
#define BARX 1
#endif
#define SEAM(k) do { if (IN(k) && IN((k) + 1)) { for (int bx_ = 0; bx_ < BARX; ++bx_) xcd_barrier(bar); } } while (0)

    if ((PHM & 1) && IN(0)) { REP(1) phase_pa(C, lds); } SEAM(0);
    if ((PHM & 2) && IN(1)) { REP(2) phase_pa2(C); } SEAM(1);
    if ((PHM & 4) && IN(2)) REP(4) { SchedBias S{C, W_SH, C.G, opaque_bid()}; EpiBias E{C}; if (GPM & 4) gemm_pipe<EpiBias, SchedBias, false>(lds, S, E); else gemm_simple(lds, S, E); } SEAM(2);

#pragma unroll 1
    for (int l = 0; l < DEPTH; ++l) {
        const int pb = 3 + 8 * l;
        if ((PHM & 8) && IN(pb + 0)) REP(8) { SchedG1 S{W_XG, W_WIN + (size_t)l * INW * D, C.G, opaque_bid()}; EpiG1 E{C, l}; if (GPM & 8) gemm_pipe<EpiG1, SchedG1, false>(lds, S, E); else gemm_simple(lds, S, E); } SEAM(pb + 0);
        if ((PHM & 16) && IN(pb + 1)) { phase_t2(C, l, (DUPM & 16) ? 2 : 1); }
        #ifndef ATTN_NAIVE
        if ((PHM & 32) && IN(pb + 2)) REP(32) { attn_body::attn_phase<8>((char*)lds_raw, W_Q, W_K, W_V, W_YMIX, W_PARTA, W_KMEAN, C.vcu, C.G); }
#else
        if ((PHM & 32) && IN(pb + 2)) { phase_attn_naive(C); }
#endif
        SEAM(pb + 2);
        if ((DUPM & 128) && IN(pb + 4)) { SchedDense S{W_YMIX, W_WOUT + (size_t)l * D * D, NTOK / 256, D / 256, D, C.G, opaque_bid()}; EpiG2 E{C, l, true}; gemm_pipe<EpiG2, SchedDense, false>(lds, S, E); }
        if ((PHM & 128) && IN(pb + 4)) { SchedDense S{W_YMIX, W_WOUT + (size_t)l * D * D, NTOK / 256, D / 256, D, C.G, opaque_bid()}; EpiG2 E{C, l, false}; if (GPM & 128) gemm_pipe<EpiG2, SchedDense, false>(lds, S, E); else gemm_simple(lds, S, E); } SEAM(pb + 4);
        if ((DUPM & 256) && IN(pb + 5)) { SchedDense S{W_XG, W_WR + (size_t)l * 256 * D, NTOK / 256, 1, D, C.G, opaque_bid()}; EpiR E{C, l, true}; gemm_pipe<EpiR, SchedDense, true, true>(lds, S, E); }
        if ((PHM & 256) && IN(pb + 5)) { SchedDense S{W_XG, W_WR + (size_t)l * 256 * D, NTOK / 256, 1, D, C.G, opaque_bid()}; EpiR E{C, l, false}; if ((GPM & 256) && C.G >= NTOK / 256) gemm_pipe<EpiR, SchedDense, true, true>(lds, S, E); } SEAM(pb + 5);
        if (IN(pb + 6) || IN(pb + 7)) {
            LAS int* tb = (LAS int*)(lds + MISC_OFF + 256); LAS int* cn = tb + 32;
            __syncthreads();
            if (opaque_tid() == 0) { int acc = 0;
                for (int k = 0; k < NCLS; ++k) { const int cnt = (int)__hip_atomic_load(W_ctl + CW_CNT + l * 2048 + k * 64, __ATOMIC_RELAXED, __HIP_MEMORY_SCOPE_AGENT); tb[k] = acc; cn[k] = cnt; acc += (cnt + 255) >> 8; }
                tb[NCLS] = acc; }
            __syncthreads();
            if ((PHM & 512) && IN(pb + 6)) REP(512) { SchedMoe S{C, l, C.G, opaque_bid(), tb, cn, false, W_XG}; EpiG3 E{C, l}; if (GPM & 512) gemm_pipe<EpiG3, SchedMoe, false, false, true>(lds, S, E); else gemm_simple(lds, S, E); } SEAM(pb + 6);
            if ((DUPM & 1024) && IN(pb + 7)) { SchedMoe S{C, l, C.G, opaque_bid(), tb, cn, true, W_HID}; EpiG4 E{C, l, true}; gemm_pipe<EpiG4, SchedMoe, false, false, true>(lds, S, E); }
            if ((PHM & 1024) && IN(pb + 7)) { SchedMoe S{C, l, C.G, opaque_bid(), tb, cn, true, W_HID}; EpiG4 E{C, l, false}; if (GPM & 1024) gemm_pipe<EpiG4, SchedMoe, false, false, true>(lds, S, E); else gemm_simple(lds, S, E); } SEAM(pb + 7);
        }
    }
#undef IN
#undef SEAM
}

extern "C" void kernel_launch(void* const* d_in, const int* in_sizes, int n_in, void* d_out, int out_size, void* d_ws, size_t ws_size, hipStream_t stream) {
    static int grid = 0;
    if (grid == 0) {
        if (n_in != 21 || out_size != NTOK * D || ws_size < WS_END) { fprintf(stderr, "kernel_launch: unexpected problem shape (n_in %d, out %d, ws %zu)\n", n_in, out_size, ws_size); grid = -1; return; }
        int dev = 0, cus = 0, per_cu = 0;
        if (hipGetDevice(&dev) != hipSuccess || hipDeviceGetAttribute(&cus, hipDeviceAttributeMultiprocessorCount, dev) != hipSuccess) { grid = -1; return; }
        if (hipFuncSetAttribute((const void*)fwd_kernel, hipFuncAttributeMaxDynamicSharedMemorySize, LDS_BYTES) != hipSuccess) { fprintf(stderr, "kernel_launch: hipFuncSetAttribute failed\n"); grid = -1; return; }
        if (hipOccupancyMaxActiveBlocksPerMultiprocessor(&per_cu, (const void*)fwd_kernel, NTHR, LDS_BYTES) != hipSuccess || per_cu < 1) { fprintf(stderr, "kernel_launch: occupancy query reports %d\n", per_cu); }
        (void)hipGetLastError();
        grid = cus;
    }
    if (grid < 0) return;
    (void)hipMemsetAsync((char*)d_ws + WS_CTL, 0, CTL_ZERO_BYTES, stream);
    Args a{};
    for (int i = 0; i < 21; ++i) a.in[i] = d_in[i];
    a.out = (float*)d_out; a.ws = (unsigned char*)d_ws;
#if MK_ONE_LAUNCH
    a.ph_lo = 0; a.ph_hi = NPHASE;
    hipLaunchKernelGGL(fwd_kernel, dim3(grid), dim3(NTHR), LDS_BYTES, stream, a);
#else
    for (int ph = 0; ph < NPHASE; ++ph) { a.ph_lo = ph; a.ph_hi = ph + 1; hipLaunchKernelGGL(fwd_kernel, dim3(grid), dim3(NTHR), LDS_BYTES, stream, a); }
#endif
}
```
